# Optimizing an MI355X kernel written in HIP

```python
import math
import jax, jax.numpy as jnp
from jax import lax
import numpy as np

D_MODEL = 1024
BATCH = 4
SEQ = 8192
DEPTH = 4

HEAD_DIM = 64
N_HEADS = D_MODEL // HEAD_DIM
SB_HEADS = N_HEADS // 2
MOBA_HEADS = N_HEADS - SB_HEADS
SWA_HEADS = N_HEADS
SWA_KV_HEADS = max(1, N_HEADS // 8)
WINDOW = 128
SB_BLOCK = 128
MOBA_BLOCK = 256
MOBA_TOPK = 3
MOBA_Q_CHUNK = 32
NUM_BUCKETS = 32
MAX_DISTANCE = 4096
MEM_LEN = 256
CROSS_HEADS = 4
CROSS_HEAD_DIM = 128
D_FF = ((8 * D_MODEL // 3 + 127) // 128) * 128
CONV_WIDTH = 3
N_EVEN = (DEPTH + 1) // 2
N_ODD = DEPTH // 2
RMS_EPS = 1e-6
NEG_INF = -1e30

kernel_name = 'hybrid_stickbreak_moba_swa_trunk'


def rms_norm(x, gain):
    xf = x.astype(jnp.float32)
    y = xf * lax.rsqrt(jnp.mean(xf * xf, axis=-1, keepdims=True) + RMS_EPS)
    return (y * gain.astype(jnp.float32)).astype(x.dtype)


def t5_bucket(dist):
    n = jnp.maximum(dist, 0)
    max_exact = NUM_BUCKETS // 2
    nf = jnp.maximum(n, 1).astype(jnp.float32)
    coef = (NUM_BUCKETS - max_exact) / math.log(MAX_DISTANCE / max_exact)
    large = max_exact + (jnp.log(nf / max_exact) * coef).astype(jnp.int32)
    large = jnp.minimum(large, NUM_BUCKETS - 1)
    return jnp.where(n < max_exact, n, large)


def stick_breaking_attention(q, k, v):
    B, H, S, D = q.shape
    scale = D ** -0.5
    pos_k = jnp.arange(S)
    vf = v.astype(jnp.float32)

    def block(c):
        start = c * SB_BLOCK
        qc = lax.dynamic_slice_in_dim(q, start, SB_BLOCK, axis=2)
        z = jnp.einsum('bhqd,bhkd->bhqk', qc, k).astype(jnp.float32) * scale
        pos_q = start + jnp.arange(SB_BLOCK)
        past = pos_k[None, :] < pos_q[:, None]
        log_not = jnp.where(past, jax.nn.log_sigmoid(-z), 0.0)
        between = lax.cumsum(log_not, axis=3, reverse=True) - log_not
        w = jnp.where(past, jnp.exp(jax.nn.log_sigmoid(z) + between), 0.0)
        return jnp.einsum('bhqk,bhkd->bhqd', w, vf).astype(q.dtype)

    out = lax.map(block, jnp.arange(S // SB_BLOCK))
    return jnp.moveaxis(out, 0, 2).reshape(B, H, S, D)


def moba_attention(q, k, v, bias_table):
    B, H, S, D = q.shape
    scale = D ** -0.5
    nb = -(-S // MOBA_BLOCK)
    pad = nb * MOBA_BLOCK - S
    kb = jnp.pad(k, ((0, 0), (0, 0), (0, pad), (0, 0))).reshape(B, H, nb, MOBA_BLOCK, D)
    vb = jnp.pad(v, ((0, 0), (0, 0), (0, pad), (0, 0))).reshape(B, H, nb, MOBA_BLOCK, D)
    k_mean = jnp.mean(kb.astype(jnp.float32), axis=3)
    n_sel = max(1, min(MOBA_TOPK, nb))
    bias_hb = bias_table.T.astype(jnp.float32)
    head_idx = jnp.arange(H)[:, None, None, None]
    offs = jnp.arange(MOBA_BLOCK)
    gather = jax.vmap(jax.vmap(lambda blocks, idx: blocks[idx]))
    n_flat = n_sel * MOBA_BLOCK

    def chunk(c):
        start = c * MOBA_Q_CHUNK
        own = start // MOBA_BLOCK
        pos_q = start + jnp.arange(MOBA_Q_CHUNK)
        qc = lax.dynamic_slice_in_dim(q, start, MOBA_Q_CHUNK, axis=2)
        gate = jnp.einsum('bhqd,bhnd->bhqn', qc.astype(jnp.float32), k_mean)
        gate = jnp.where(jnp.arange(nb) < own, gate, NEG_INF)
        _, idx = lax.top_k(gate, n_sel)
        valid = jnp.arange(n_sel) < own
        kg = gather(kb, idx)
        vg = gather(vb, idx)
        dist_sel = pos_q[:, None, None] - (idx[..., None] * MOBA_BLOCK + offs)
        s_sel = (jnp.einsum('bhqd,bhqnld->bhqnl', qc, kg).astype(jnp.float32) * scale
                 + bias_hb[head_idx, t5_bucket(dist_sel)])
        s_sel = jnp.where(valid[:, None], s_sel, NEG_INF).reshape(B, H, MOBA_Q_CHUNK, n_flat)
        k_own = lax.dynamic_index_in_dim(kb, own, axis=2, keepdims=False)
        v_own = lax.dynamic_index_in_dim(vb, own, axis=2, keepdims=False)
        dist_own = pos_q[:, None] - (own * MOBA_BLOCK + offs)[None, :]
        s_own = (jnp.einsum('bhqd,bhld->bhql', qc, k_own).astype(jnp.float32) * scale
                 + bias_hb[:, t5_bucket(dist_own)])
        s_own = jnp.where(dist_own >= 0, s_own, NEG_INF)
        p = jax.nn.softmax(jnp.concatenate([s_sel, s_own], axis=-1), axis=-1)
        p_sel = p[..., :n_flat].reshape(B, H, MOBA_Q_CHUNK, n_sel, MOBA_BLOCK)
        p_own = p[..., n_flat:]
        out = (jnp.einsum('bhqnl,bhqnld->bhqd', p_sel, vg.astype(jnp.float32))
               + jnp.einsum('bhql,bhld->bhqd', p_own, v_own.astype(jnp.float32)))
        return out.astype(q.dtype)

    out = lax.map(chunk, jnp.arange(S // MOBA_Q_CHUNK))
    return jnp.moveaxis(out, 0, 2).reshape(B, H, S, D)


def swa_sink_attention(q, k, v, sinks, bias_table):
    B, S, Hq, D = q.shape
    Hkv = k.shape[2]
    G = Hq // Hkv
    blk = WINDOW
    nqb = S // blk
    scale = D ** -0.5
    qb = q.reshape(B, nqb, blk, Hkv, G, D)

    def band(t):
        tb = t.reshape(B, nqb, blk, Hkv, D)
        prev = jnp.pad(tb, ((0, 0), (1, 0), (0, 0), (0, 0), (0, 0)))[:, :-1]
        return jnp.concatenate([prev, tb], axis=2)

    kk, vv = band(k), band(v)
    qi = jnp.arange(blk)
    kj = jnp.arange(2 * blk)
    dist = qi[:, None] + blk - kj[None, :]
    in_window = (dist >= 0) & (dist < WINDOW)
    key_exists = (jnp.arange(nqb)[:, None, None] * blk - blk + kj[None, None, :]) >= 0
    mask = in_window[None] & key_exists
    bias = bias_table.astype(jnp.float32)[t5_bucket(dist)]
    bias = jnp.transpose(bias, (2, 0, 1)).reshape(Hkv, G, 1, blk, 2 * blk)
    s = jnp.einsum('bnqhgd,bnkhd->bhgnqk', qb, kk).astype(jnp.float32) * scale + bias
    s = jnp.where(mask, s, NEG_INF)
    sink = sinks.astype(jnp.float32).reshape(Hkv, G)[:, :, None, None, None]
    m = jnp.maximum(jnp.max(s, axis=-1, keepdims=True), sink)
    p = jnp.exp(s - m)
    denom = jnp.sum(p, axis=-1, keepdims=True) + jnp.exp(sink - m)
    out = jnp.einsum('bhgnqk,bnkhd->bnqhgd', p / denom, vv.astype(jnp.float32))
    return out.reshape(B, S, Hq * D).astype(q.dtype)


def even_mixer(h, w_in, w_out, q_gain, k_gain, bias_table):
    B, S, _ = h.shape
    qa, ka, va, qm, km, vm = jnp.split(h @ w_in, 6, axis=-1)

    def heads(t, n):
        return t.reshape(B, S, n, HEAD_DIM).transpose(0, 2, 1, 3)

    out_a = stick_breaking_attention(heads(qa, SB_HEADS), heads(ka, SB_HEADS), heads(va, SB_HEADS))
    qm = rms_norm(heads(qm, MOBA_HEADS), q_gain)
    km = rms_norm(heads(km, MOBA_HEADS), k_gain)
    out_b = moba_attention(qm, km, heads(vm, MOBA_HEADS), bias_table[:, SB_HEADS:])
    out = jnp.concatenate([out_a, out_b], axis=1).transpose(0, 2, 1, 3).reshape(B, S, N_HEADS * HEAD_DIM)
    return out @ w_out


def odd_mixer(h, w_in, w_out, q_gain, k_gain, sinks, bias_table):
    B, S, _ = h.shape
    q, k, v = jnp.split(h @ w_in, [SWA_HEADS * HEAD_DIM, (SWA_HEADS + SWA_KV_HEADS) * HEAD_DIM], axis=-1)
    q = rms_norm(q.reshape(B, S, SWA_HEADS, HEAD_DIM), q_gain)
    k = rms_norm(k.reshape(B, S, SWA_KV_HEADS, HEAD_DIM), k_gain)
    v = v.reshape(B, S, SWA_KV_HEADS, HEAD_DIM)
    return swa_sink_attention(q, k, v, sinks, bias_table) @ w_out


def memory_cross_attention(h, mem_n, w_q, w_kv, w_o, q_gain, k_gain):
    B, S, _ = h.shape
    M = mem_n.shape[1]
    q = rms_norm((h @ w_q).reshape(B, S, CROSS_HEADS, CROSS_HEAD_DIM), q_gain)
    k, v = jnp.split(mem_n @ w_kv, 2, axis=-1)
    k = rms_norm(k.reshape(B, M, CROSS_HEADS, CROSS_HEAD_DIM), k_gain)
    v = v.reshape(B, M, CROSS_HEADS, CROSS_HEAD_DIM)
    s = jnp.einsum('bshd,bmhd->bhsm', q, k).astype(jnp.float32) * (CROSS_HEAD_DIM ** -0.5)
    p = jax.nn.softmax(s, axis=-1)
    o = jnp.einsum('bhsm,bmhd->bshd', p, v.astype(jnp.float32)).astype(h.dtype)
    return o.reshape(B, S, CROSS_HEADS * CROSS_HEAD_DIM) @ w_o


def conv_ffn(h, w_in, conv_w, conv_b, w_out):
    S = h.shape[1]
    u = h @ w_in
    u_pad = jnp.pad(u, ((0, 0), (CONV_WIDTH - 1, 0), (0, 0)))
    c = conv_b
    for i in range(CONV_WIDTH):
        c = c + conv_w[i] * u_pad[:, i:i + S]
    gate, up = jnp.split(c, 2, axis=-1)
    return (jax.nn.silu(gate) * up) @ w_out


def setup_inputs(seed: int = 0) -> dict:
    key = jax.random.key(seed)
    ks = jax.random.split(key, 32)
    f32 = jnp.float32

    def nrm(k, shape, scale):
        return jax.random.normal(k, shape, f32) * scale

    def gain(k, shape):
        return 1.0 + 0.05 * jax.random.normal(k, shape, f32)

    D = D_MODEL
    mix_w = N_HEADS * HEAD_DIM
    ev_in = 3 * (SB_HEADS + MOBA_HEADS) * HEAD_DIM
    od_in = (SWA_HEADS + 2 * SWA_KV_HEADS) * HEAD_DIM
    cw = CROSS_HEADS * CROSS_HEAD_DIM
    return {
        'x': nrm(ks[0], (BATCH, SEQ, D), 1.0),
        'mem': nrm(ks[1], (BATCH, MEM_LEN, D), 1.0),
        'rel_bias': nrm(ks[2], (NUM_BUCKETS, N_HEADS), 0.2),
        'mix_norm': gain(ks[3], (DEPTH, D)),
        'ev_w_in': nrm(ks[4], (N_EVEN, D, ev_in), D ** -0.5),
        'ev_w_out': nrm(ks[5], (N_EVEN, mix_w, D), 0.5 * mix_w ** -0.5),
        'ev_q_gain': gain(ks[6], (N_EVEN, HEAD_DIM)),
        'ev_k_gain': gain(ks[7], (N_EVEN, HEAD_DIM)),
        'od_w_in': nrm(ks[8], (N_ODD, D, od_in), D ** -0.5),
        'od_w_out': nrm(ks[9], (N_ODD, mix_w, D), 0.5 * mix_w ** -0.5),
        'od_q_gain': gain(ks[10], (N_ODD, HEAD_DIM)),
        'od_k_gain': gain(ks[11], (N_ODD, HEAD_DIM)),
        'od_sinks': nrm(ks[12], (N_ODD, SWA_HEADS), 0.5),
        'cx_norm': gain(ks[13], (DEPTH, D)),
        'cx_mem_norm': gain(ks[14], (DEPTH, D)),
        'cx_w_q': nrm(ks[15], (DEPTH, D, cw), D ** -0.5),
        'cx_w_kv': nrm(ks[16], (DEPTH, D, 2 * cw), D ** -0.5),
        'cx_w_o': nrm(ks[17], (DEPTH, cw, D), 0.5 * cw ** -0.5),
        'cx_q_gain': gain(ks[18], (DEPTH, CROSS_HEAD_DIM)),
        'cx_k_gain': gain(ks[19], (DEPTH, CROSS_HEAD_DIM)),
        'ff_norm': gain(ks[20], (DEPTH, D)),
        'ff_w_in': nrm(ks[21], (DEPTH, D, 2 * D_FF), D ** -0.5),
        'ff_conv_w': nrm(ks[22], (DEPTH, CONV_WIDTH, 2 * D_FF), CONV_WIDTH ** -0.5),
        'ff_conv_b': nrm(ks[23], (DEPTH, 2 * D_FF), 0.02),
        'ff_w_out': nrm(ks[24], (DEPTH, D_FF, D), 0.5 * D_FF ** -0.5),
    }


def reference(x, mem, rel_bias, mix_norm, ev_w_in, ev_w_out, ev_q_gain, ev_k_gain,
              od_w_in, od_w_out, od_q_gain, od_k_gain, od_sinks,
              cx_norm, cx_mem_norm, cx_w_q, cx_w_kv, cx_w_o, cx_q_gain, cx_k_gain,
              ff_norm, ff_w_in, ff_conv_w, ff_conv_b, ff_w_out):
    for layer in range(DEPTH):
        i = layer // 2
        h = rms_norm(x, mix_norm[layer])
        if layer % 2 == 0:
            x = x + even_mixer(h, ev_w_in[i], ev_w_out[i], ev_q_gain[i], ev_k_gain[i], rel_bias)
        else:
            x = x + odd_mixer(h, od_w_in[i], od_w_out[i], od_q_gain[i], od_k_gain[i],
                              od_sinks[i], rel_bias)
        x = x + memory_cross_attention(rms_norm(x, cx_norm[layer]), rms_norm(mem, cx_mem_norm[layer]),
                                       cx_w_q[layer], cx_w_kv[layer], cx_w_o[layer],
                                       cx_q_gain[layer], cx_k_gain[layer])
        x = x + conv_ffn(rms_norm(x, ff_norm[layer]), ff_w_in[layer], ff_conv_w[layer],
                         ff_conv_b[layer], ff_w_out[layer])
    return x
```

```cpp
#include <hip/hip_runtime.h>
#include <hip/hip_cooperative_groups.h>
#include <cstdio>
#include <cstdint>
#include <cmath>
namespace cg = cooperative_groups;
namespace pg8 {
#define PG8_LAS __attribute__((address_space(3)))
typedef unsigned short bf16_t;
typedef short bf16x8 __attribute__((ext_vector_type(8)));
typedef float f32x4 __attribute__((ext_vector_type(4)));
typedef unsigned u32x4 __attribute__((ext_vector_type(4)));
constexpr int BM = 256, BK = 64, HALF = 128, HTB = HALF * BK * 2  , STAGE_BYTES = 8 * HTB, NXCD = 8, WGM = 4;

__host__ __device__ __forceinline__ int lds_byte(int r, int c) { const int st = (r >> 4) * 2 + (c >> 5), rr = r & 15, cc = c & 31, ob = rr * 64 + cc * 2; return st * 1024 + (ob ^ (((ob >> 9) & 1) << 5)); }
__host__ __device__ __forceinline__ void stage_rc(int b, int& R, int& C) { const int st = b / 1024, sb = b % 1024, swz = sb ^ (((sb >> 9) & 1) << 5); R = (st >> 1) * 16 + swz / 64; C = (st & 1) * 32 + (swz % 64) / 2; }
__host__ __device__ __forceinline__ int perm32(int rho) { const int n = rho >> 4, i = rho & 15; return 8 * (i >> 2) + 4 * n + (i & 3); }

struct Unit { int pm, pn; };
struct Gemm { const bf16_t* A; const bf16_t* Bt; int M, N, K; };

struct StaticOrder {
    int nM, nN, nwg, G, c, wgm;
    __host__ __device__ void init(int M, int N, int G_, int c_, int wgm_ = WGM) { nM = M / BM; nN = N / BM; nwg = nM * nN; G = G_; c = c_; wgm = wgm_; }
    __host__ __device__ bool next(int i, Unit& u) const {
        const long L = (long)i * G + c; if (L >= nwg) return false;
        int wgid = (int)L; { const int q = nwg / NXCD, r = nwg % NXCD, xcd = wgid % NXCD, off = wgid / NXCD; wgid = (xcd < r ? xcd * (q + 1) : r * (q + 1) + (xcd - r) * q) + off; }
        const int nig = wgm * nN, gid = wgid / nig, fm = gid * wgm, gsz = (nM - fm) < wgm ? (nM - fm) : wgm;
        u.pm = fm + ((wgid % nig) % gsz); u.pn = (wgid % nig) / gsz; return true;
    }
    __device__ __forceinline__ void a_ready(const Unit&) const {}
    __device__ __forceinline__ void done(const Unit&) const {}
};

__device__ __forceinline__ unsigned cvt_pk_bf16(float lo, float hi) { unsigned r; asm volatile("v_cvt_pk_bf16_f32 %0, %1, %2" : "=v"(r) : "v"(lo), "v"(hi)); return r; }

typedef PG8_LAS float lfloat;
#ifndef RESID_F16
#define RESID_F16 0
#endif
typedef _Float16 f16x8_t __attribute__((ext_vector_type(8))); typedef _Float16 f16x2_t __attribute__((ext_vector_type(2))); typedef float f32x2p_t __attribute__((ext_vector_type(2)));
template <bool F16> __device__ __forceinline__ f32x4 mma16(bf16x8 b, bf16x8 a, f32x4 c) {
    if constexpr (F16) return __builtin_amdgcn_mfma_f32_16x16x32_f16(__builtin_bit_cast(f16x8_t, b), __builtin_bit_cast(f16x8_t, a), c, 0, 0, 0);
    else return __builtin_amdgcn_mfma_f32_16x16x32_bf16(b, a, c, 0, 0, 0);
}
__device__ __forceinline__ unsigned pk2h(float lo, float hi) { const f32x2p_t v = {lo, hi}; const f16x2_t hv = __builtin_convertvector(v, f16x2_t); return __builtin_bit_cast(unsigned, hv); }
__device__ __forceinline__ f32x2p_t unpk2h(unsigned w) { return __builtin_convertvector(__builtin_bit_cast(f16x2_t, w), f32x2p_t); }
__device__ __forceinline__ int opaque_tid() { int t = threadIdx.x; asm volatile("" : "+v"(t)); return t; }
__device__ __forceinline__ float dpp_ror1(float v) { return __builtin_bit_cast(float, __builtin_amdgcn_update_dpp(0, __builtin_bit_cast(int, v), 0x121, 0xf, 0xf, false)); }
__device__ __forceinline__ float dpp_ror2(float v) { return __builtin_bit_cast(float, __builtin_amdgcn_update_dpp(0, __builtin_bit_cast(int, v), 0x122, 0xf, 0xf, false)); }
__device__ __forceinline__ float dpp_ror4(float v) { return __builtin_bit_cast(float, __builtin_amdgcn_update_dpp(0, __builtin_bit_cast(int, v), 0x124, 0xf, 0xf, false)); }
__device__ __forceinline__ float dpp_ror8(float v) { return __builtin_bit_cast(float, __builtin_amdgcn_update_dpp(0, __builtin_bit_cast(int, v), 0x128, 0xf, 0xf, false)); }
__device__ __forceinline__ float row16_sum(float v) {
    asm volatile("s_nop 1\n\tv_add_f32_dpp %0, %0, %0 row_ror:8 row_mask:0xf bank_mask:0xf\n\ts_nop 1\n\tv_add_f32_dpp %0, %0, %0 row_ror:4 row_mask:0xf bank_mask:0xf\n\t"
                 "s_nop 1\n\tv_add_f32_dpp %0, %0, %0 row_ror:2 row_mask:0xf bank_mask:0xf\n\ts_nop 1\n\tv_add_f32_dpp %0, %0, %0 row_ror:1 row_mask:0xf bank_mask:0xf" : "+v"(v));
    return v; }
__device__ __forceinline__ float fq_sum(float v) {
    auto a = __builtin_amdgcn_permlane32_swap(__float_as_uint(v), __float_as_uint(v), false, false); v = __uint_as_float(a[0]) + __uint_as_float(a[1]);
    auto b = __builtin_amdgcn_permlane16_swap(__float_as_uint(v), __float_as_uint(v), false, false); return __uint_as_float(b[0]) + __uint_as_float(b[1]); }
#define EPI_BAR() do { asm volatile("s_waitcnt lgkmcnt(0)" ::: "memory"); __builtin_amdgcn_s_barrier(); asm volatile("" ::: "memory"); } while (0)

template <int MODE> struct EpiProj {
    static constexpr bool PERM = true, AFTER_DRAIN = false, F16A = (RESID_F16 != 0) && (MODE != 3), ROWPERM = false;
    bf16_t* O; int ldc; lfloat* rtab; lfloat* exch; const float* g0; const float* g1; float* km2;
    __device__ __forceinline__ void operator()(f32x4 (&acc)[2][2][4][2], const Unit& u, int ui, int wr, int wc, int fr_, int fq_) const {
        int fr = fr_, fq = fq_; asm volatile("" : "+v"(fr), "+v"(fq));
#pragma unroll
        for (int ai = 0; ai < 2; ++ai)
#pragma unroll
            for (int m = 0; m < 4; ++m) { const float r = rtab[ui * 256 + ai * HALF + wr * 64 + m * 16 + fr];
#pragma unroll
                for (int bj = 0; bj < 2; ++bj)
#pragma unroll
                    for (int n = 0; n < 2; ++n) acc[ai][bj][m][n] = acc[ai][bj][m][n] * r; }
        const float* gpa = nullptr; const float* gpb = nullptr; constexpr int HW = 64;
        if (MODE == 0) { const int seg = u.pn >> 1; if (seg == 3) { gpa = g0; gpb = g0; } else if (seg == 4) { gpa = g1; gpb = g1; } }
        if (MODE == 1) { if (u.pn < 4) { gpa = g0; gpb = g0; } else { gpa = g1; } }
        if (gpa != nullptr || gpb != nullptr) {
#pragma unroll
            for (int ai = 0; ai < 2; ++ai)
#pragma unroll
                for (int m = 0; m < 4; ++m)
#pragma unroll
                    for (int bj = 0; bj < 2; ++bj) { float s = 0.f;
#pragma unroll
                        for (int n = 0; n < 2; ++n) { const f32x4 x = acc[ai][bj][m][n]; s += (x[0] * x[0] + x[1] * x[1]) + (x[2] * x[2] + x[3] * x[3]); }
                        s = fq_sum(s);
                        if (fq == 0) exch[(bj * 256 + ai * HALF + wr * 64 + m * 16 + fr) * 4 + wc] = s; }
            EPI_BAR();
#pragma unroll
            for (int bj = 0; bj < 2; ++bj) { const float* gp = bj == 0 ? gpa : gpb;
                if (gp != nullptr) {
                    const int ch = (HW == 64 ? 32 * (wc & 1) : 32 * wc) + 8 * fq;
                    const f32x4 ga = *(const f32x4*)(gp + ch), gb = *(const f32x4*)(gp + ch + 4);
#pragma unroll
                    for (int ai = 0; ai < 2; ++ai)
#pragma unroll
                        for (int m = 0; m < 4; ++m) { const int e = (bj * 256 + ai * HALF + wr * 64 + m * 16 + fr) * 4; float tot;
                            if (HW == 64) tot = exch[e + wc] + exch[e + (wc ^ 1)]; else { const f32x4 t4 = *(const PG8_LAS f32x4*)(exch + e); tot = (t4[0] + t4[1]) + (t4[2] + t4[3]); }
                            const float rn = __builtin_amdgcn_rsqf(tot * (1.0f / HW) + 1e-6f);
                            acc[ai][bj][m][0] = acc[ai][bj][m][0] * rn * ga; acc[ai][bj][m][1] = acc[ai][bj][m][1] * rn * gb; asm volatile("" ::: "memory"); }
                }
            }
        }
        if (MODE == 0) { if ((u.pn >> 1) == 4) {
#pragma unroll
            for (int bj = 0; bj < 2; ++bj)
#pragma unroll
                for (int n = 0; n < 2; ++n) { f32x4 cs = (f32x4){0.f, 0.f, 0.f, 0.f};
#pragma unroll
                    for (int ai = 0; ai < 2; ++ai)
#pragma unroll
                        for (int m = 0; m < 4; ++m) cs = cs + acc[ai][bj][m][n];
                    cs[0] = row16_sum(cs[0]); cs[1] = row16_sum(cs[1]); cs[2] = row16_sum(cs[2]); cs[3] = row16_sum(cs[3]);
                    if (fr == 0) *(f32x4*)(km2 + (size_t)(u.pm * 2 + wr) * 512 + (u.pn - 8) * 256 + bj * HALF + wc * 32 + 8 * fq + 4 * n) = cs; }
        } }
        const int row0 = u.pm * BM + wr * 64 + fr, col0 = u.pn * BM + wc * 32 + 8 * fq;
#pragma unroll
        for (int ai = 0; ai < 2; ++ai)
#pragma unroll
            for (int m = 0; m < 4; ++m) {
#pragma unroll
                for (int bj = 0; bj < 2; ++bj) { const f32x4 v0 = acc[ai][bj][m][0], v1 = acc[ai][bj][m][1]; u32x4 w;
                    w.x = cvt_pk_bf16(v0[0], v0[1]); w.y = cvt_pk_bf16(v0[2], v0[3]); w.z = cvt_pk_bf16(v1[0], v1[1]); w.w = cvt_pk_bf16(v1[2], v1[3]);
                    const int row = row0 + ai * HALF + m * 16;
                    if (MODE == 0) {
                        const int hd = (u.pn & 1) * 4 + bj * 2 + (wc >> 1), d = (wc & 1) * 32 + 8 * fq;
                        *(u32x4*)(O + (size_t)(u.pn >> 1) * ((size_t)32768 * 512) + ((size_t)((row >> 13) * 8 + hd) * 8192 + (row & 8191)) * 64 + d) = w;
                    } else *(u32x4*)(O + (size_t)row * ldc + col0 + bj * HALF) = w; } }
    }
};

template <bool IN32, bool OUT32> struct EpiRes {
    static constexpr bool PERM = true, AFTER_DRAIN = false, F16A = false, ROWPERM = false;
    const float* Xin32; float* Xout32; bf16_t* XB; float* SS;
    __device__ __forceinline__ void operator()(f32x4 (&acc)[2][2][4][2], const Unit& u, int ui, int wr, int wc, int fr_, int fq_) const {
        int fr = fr_, fq = fq_; asm volatile("" : "+v"(fr), "+v"(fq));
        const int row0 = u.pm * BM + wr * 64 + fr, col0 = u.pn * BM + wc * 32 + 8 * fq;
#pragma unroll
        for (int ai = 0; ai < 2; ++ai)
#pragma unroll
            for (int m = 0; m < 4; ++m) { const size_t off = (size_t)(row0 + ai * HALF + m * 16) * 1024 + col0; float s = 0.f;
#pragma unroll
                for (int bj = 0; bj < 2; ++bj) { f32x4 v0, v1;
                    if (IN32) { const float* xi = Xin32 + off + bj * HALF; v0 = *(const f32x4*)xi; v1 = *(const f32x4*)(xi + 4); }
                    else { const u32x4 w = *(const u32x4*)(XB + off + bj * HALF);
                        if (RESID_F16) { const f32x2p_t a = unpk2h(w.x), b = unpk2h(w.y), c2 = unpk2h(w.z), d = unpk2h(w.w); v0 = (f32x4){a.x, a.y, b.x, b.y}; v1 = (f32x4){c2.x, c2.y, d.x, d.y}; }
                        else { v0 = (f32x4){__builtin_bit_cast(float, w.x << 16), __builtin_bit_cast(float, w.x & 0xffff0000u), __builtin_bit_cast(float, w.y << 16), __builtin_bit_cast(float, w.y & 0xffff0000u)};
                               v1 = (f32x4){__builtin_bit_cast(float, w.z << 16), __builtin_bit_cast(float, w.z & 0xffff0000u), __builtin_bit_cast(float, w.w << 16), __builtin_bit_cast(float, w.w & 0xffff0000u)}; } }
                    v0 = v0 + acc[ai][bj][m][0]; v1 = v1 + acc[ai][bj][m][1];
                    if (OUT32) { float* xp = Xout32 + off + bj * HALF; __builtin_nontemporal_store(v0, (f32x4*)xp); __builtin_nontemporal_store(v1, (f32x4*)(xp + 4)); }
                    s += (v0[0] * v0[0] + v0[1] * v0[1]) + (v0[2] * v0[2] + v0[3] * v0[3]) + (v1[0] * v1[0] + v1[1] * v1[1]) + (v1[2] * v1[2] + v1[3] * v1[3]);
                    u32x4 w; if (RESID_F16) { w.x = pk2h(v0[0], v0[1]); w.y = pk2h(v0[2], v0[3]); w.z = pk2h(v1[0], v1[1]); w.w = pk2h(v1[2], v1[3]); } else { w.x = cvt_pk_bf16(v0[0], v0[1]); w.y = cvt_pk_bf16(v0[2], v0[3]); w.z = cvt_pk_bf16(v1[0], v1[1]); w.w = cvt_pk_bf16(v1[2], v1[3]); }
                    *(u32x4*)(XB + off + bj * HALF) = w; }
                s = fq_sum(s);
                if (fq == 0) SS[(size_t)(row0 + ai * HALF + m * 16) * 16 + u.pn * 4 + wc] = s;
                asm volatile("" ::: "memory"); }
    }
};

struct EpiFfnUp {
    static constexpr bool PERM = true, AFTER_DRAIN = false, ROWPERM = true, F16A = (RESID_F16 != 0);
    bf16_t* G; lfloat* rtab; lfloat* exch; const float* cw; const float* cb; float* halo;
    __device__ __forceinline__ void operator()(f32x4 (&acc)[2][2][4][2], const Unit& u, int ui, int wr, int wc, int fr_, int fq_) const {
        int fr = fr_, fq = fq_; asm volatile("" : "+v"(fr), "+v"(fq));
        { const PG8_LAS f32x4* rp = (const PG8_LAS f32x4*)(rtab + ui * 256 + (fr + 16 * wr) * 8); const f32x4 r0 = rp[0], r1 = rp[1];
#pragma unroll
          for (int ai = 0; ai < 2; ++ai)
#pragma unroll
              for (int m = 0; m < 4; ++m) { const float r = ai == 0 ? r0[m] : r1[m];
#pragma unroll
                  for (int bj = 0; bj < 2; ++bj)
#pragma unroll
                      for (int n = 0; n < 2; ++n) acc[ai][bj][m][n] = acc[ai][bj][m][n] * r; } }
        const int fbase = u.pn * 128 + 32 * wc + 8 * fq;
        {
            const bool lo = (wr == 0 && fr == 0), hi = (wr == 1 && fr == 15);
            if (lo || hi) { float* hp = halo + (size_t)(u.pm * 4 + (hi ? 2 : 0)) * 5632 + fbase; asm volatile("" : "+v"(hp));
#pragma unroll
                for (int bj = 0; bj < 2; ++bj)
#pragma unroll
                    for (int n = 0; n < 2; ++n) { const f32x4 a = hi ? acc[1][bj][2][n] : acc[0][bj][0][n], b2 = hi ? acc[1][bj][3][n] : acc[0][bj][1][n];
                        *(f32x4*)(hp + bj * 2816 + 4 * n) = a; *(f32x4*)(hp + 5632 + bj * 2816 + 4 * n) = b2; } }
        }
        if (wr == 0 && fr == 15) {
#pragma unroll
            for (int bj = 0; bj < 2; ++bj)
#pragma unroll
                for (int n = 0; n < 2; ++n) { *(PG8_LAS f32x4*)(exch + (0 * 256 + bj * HALF + 32 * wc + 8 * fq + 4 * n)) = acc[1][bj][2][n]; *(PG8_LAS f32x4*)(exch + (1 * 256 + bj * HALF + 32 * wc + 8 * fq + 4 * n)) = acc[1][bj][3][n]; }
        }
        EPI_BAR();
        bf16_t* gbase = G + (size_t)(u.pm * BM + (fr + 16 * wr) * 8) * 2816 + fbase;
#pragma unroll
        for (int n = 0; n < 2; ++n) {
#pragma unroll
            for (int bj = 0; bj < 2; ++bj) { const int ch = bj * 2816 + fbase + 4 * n;
                const f32x4 w0 = *(const f32x4*)(cw + ch), w1 = *(const f32x4*)(cw + 5632 + ch), w2 = *(const f32x4*)(cw + 2 * 5632 + ch), bb = *(const f32x4*)(cb + ch);
                const PG8_LAS float* ex = exch + (bj * HALF + 32 * wc + 8 * fq + 4 * n);
#pragma unroll
                for (int j4 = 0; j4 < 4; ++j4) {
                    float c6 = ex[j4], c7 = ex[256 + j4];
                    asm volatile("s_waitcnt lgkmcnt(0)\n\ts_nop 1\n\tv_mov_b32_dpp %0, %2 row_shr:1 row_mask:0xf bank_mask:0xf\n\tv_mov_b32_dpp %1, %3 row_shr:1 row_mask:0xf bank_mask:0xf"
                                 : "+v"(c6), "+v"(c7) : "v"(acc[1][bj][2][n][j4]), "v"(acc[1][bj][3][n][j4]));
#define AX(j) acc[(j) >> 2][bj][(j) & 3][n][j4]
                    const float bq = bb[j4], q0 = w0[j4], q1 = w1[j4], q2 = w2[j4];
                    AX(7) = bq + q0 * AX(5) + q1 * AX(6) + q2 * AX(7); AX(6) = bq + q0 * AX(4) + q1 * AX(5) + q2 * AX(6);
                    AX(5) = bq + q0 * AX(3) + q1 * AX(4) + q2 * AX(5); AX(4) = bq + q0 * AX(2) + q1 * AX(3) + q2 * AX(4);
                    AX(3) = bq + q0 * AX(1) + q1 * AX(2) + q2 * AX(3); AX(2) = bq + q0 * AX(0) + q1 * AX(1) + q2 * AX(2);
                    AX(1) = bq + q0 * c7 + q1 * AX(0) + q2 * AX(1);    AX(0) = bq + q0 * c6 + q1 * c7 + q2 * AX(0);
#undef AX
                }
            }
            bf16_t* gp = gbase + 4 * n;
#pragma unroll
            for (int j = 0; j < 8; ++j) { float gv[4];
#pragma unroll
                for (int k = 0; k < 4; ++k) { const float g = acc[j >> 2][0][j & 3][n][k], up = acc[j >> 2][1][j & 3][n][k]; gv[k] = g * __builtin_amdgcn_rcpf(1.0f + __builtin_amdgcn_exp2f(g * -1.4426950408889634f)) * up; }
                typedef unsigned u32x2_t __attribute__((ext_vector_type(2))); u32x2_t w; w.x = cvt_pk_bf16(gv[0], gv[1]); w.y = cvt_pk_bf16(gv[2], gv[3]);
                *(u32x2_t*)gp = w; gp += 2816; asm volatile("" : "+v"(gp) :: "memory"); }
        }
    }
};
template <class Epi, class Sched, bool ALIGN_EPI = false, bool SP2 = false>
__device__ __forceinline__ void gemm_phase(PG8_LAS unsigned char* lds, const Gemm g, const Sched& S, const Epi& E) {
    const int tid = opaque_tid(), wid = __builtin_amdgcn_readfirstlane(tid >> 6), lane = tid & 63, wr = wid >> 2, wc = wid & 3, fr = lane & 15, fq = lane >> 4;
    const int K = g.K, nt = K / BK;
    unsigned voffA[2], voffB[2];
#pragma unroll
    for (int i = 0; i < 2; ++i) { int R, C; stage_rc(tid * 16 + i * 8192, R, C); const int Rb = Epi::PERM ? ((R & ~31) + perm32(R & 31)) : R;
        const int Ra = Epi::ROWPERM ? (((R & 15) + 16 * (R >> 6)) * 8 + ((R >> 4) & 3)) : R;
        voffA[i] = (unsigned)(Ra * K + C) * 2u; voffB[i] = (unsigned)(Rb * K + C) * 2u; }
    const size_t kstep = (size_t)(BK * 2);
    const size_t hstep = (size_t)HALF * K * 2;
    const size_t hstepA = Epi::ROWPERM ? (size_t)4 * K * 2 : hstep;
    const size_t tstep = 2 * hstep;
    const unsigned ldsw = (unsigned)wid * 1024u;
    const int aoff = lds_byte(wr * 64 + fr, fq * 8), boff = lds_byte(wc * 32 + fr, fq * 8);
#define PG8_SA(b, h) (((b) * 2 + (h)) * HTB)
#define PG8_SB(b, h) ((4 + (b) * 2 + (h)) * HTB)
#define PG8_STAGE(bufoff, gbase, voff) do { _Pragma("unroll") for (int _i = 0; _i < 2; ++_i) \
        __builtin_amdgcn_global_load_lds((const unsigned*)((const char*)(gbase) + (voff)[_i]), (PG8_LAS unsigned*)(lds + (bufoff) + ldsw + _i * 8192), 16, 0, 0); } while (0)
#define PG8_LDA(dst, b, h) do { _Pragma("unroll") for (int m = 0; m < 4; ++m) _Pragma("unroll") for (int k = 0; k < 2; ++k) dst[m][k] = *(const PG8_LAS bf16x8*)(lds + PG8_SA(b, h) + aoff + m * 2048 + k * 1024); } while (0)
#define PG8_LDB(dst, b, h) do { _Pragma("unroll") for (int n = 0; n < 2; ++n) _Pragma("unroll") for (int k = 0; k < 2; ++k) dst[n][k] = *(const PG8_LAS bf16x8*)(lds + PG8_SB(b, h) + boff + n * 2048 + k * 1024); } while (0)
#define PG8_MMA(ai, bj, At, Bt) do { __builtin_amdgcn_s_setprio(1); _Pragma("unroll") for (int m = 0; m < 4; ++m) _Pragma("unroll") for (int n = 0; n < 2; ++n) _Pragma("unroll") for (int k = 0; k < 2; ++k) \
        acc[ai][bj][m][n] = mma16<Epi::F16A>(Bt[n][k], At[m][k], acc[ai][bj][m][n]); __builtin_amdgcn_s_setprio(0); } while (0)
#define PG8_WAIT_V(n) asm volatile("s_waitcnt vmcnt(" #n ")" ::: "memory")
#define PG8_WAIT_L(n) asm volatile("s_waitcnt lgkmcnt(" #n ")" ::: "memory")
#define PG8_BAR __builtin_amdgcn_s_barrier()
#define PG8_SCHED __builtin_amdgcn_sched_barrier(0)
    Unit cur, nxt; int ui = 0;
    if (!S.next(0, cur)) return;
    f32x4 acc[2][2][4][2];
#pragma unroll
    for (int a = 0; a < 2; ++a)
#pragma unroll
        for (int b = 0; b < 2; ++b)
#pragma unroll
            for (int m = 0; m < 4; ++m)
#pragma unroll
                for (int n = 0; n < 2; ++n) acc[a][b][m][n] = (f32x4){0.f, 0.f, 0.f, 0.f};
    bf16x8 At[4][2], B0[2][2], B1[2][2];
    const char* cA = (const char*)g.A + (size_t)cur.pm * tstep; const char* cB = (const char*)g.Bt + (size_t)cur.pn * tstep;
    S.a_ready(cur);
    if constexpr (SP2) {
        PG8_STAGE(PG8_SB(0, 0), cB, voffB); PG8_STAGE(PG8_SB(0, 1), cB + hstep, voffB); PG8_STAGE(PG8_SA(0, 0), cA, voffA); PG8_STAGE(PG8_SA(0, 1), cA + hstepA, voffA);
        if (wr == 1) PG8_BAR;
        PG8_WAIT_V(2); PG8_BAR;
        PG8_STAGE(PG8_SB(1, 0), cB + kstep, voffB); PG8_STAGE(PG8_SA(1, 0), cA + kstep, voffA); PG8_STAGE(PG8_SB(1, 1), cB + hstep + kstep, voffB);
        PG8_WAIT_V(6); PG8_BAR;
    } else {
        PG8_STAGE(PG8_SB(0, 0), cB, voffB); PG8_STAGE(PG8_SA(0, 0), cA, voffA); PG8_STAGE(PG8_SB(0, 1), cB + hstep, voffB); PG8_STAGE(PG8_SA(0, 1), cA + hstepA, voffA);
        if (wr == 1) PG8_BAR;
        PG8_WAIT_V(4); PG8_BAR;
        PG8_STAGE(PG8_SB(1, 0), cB + kstep, voffB); PG8_STAGE(PG8_SA(1, 0), cA + kstep, voffA); PG8_STAGE(PG8_SB(1, 1), cB + hstep + kstep, voffB);
        PG8_WAIT_V(6); PG8_BAR;
    }
    for (;;) {
        const bool has_next = S.next(ui + 1, nxt);
        const char* nA = has_next ? (const char*)g.A + (size_t)nxt.pm * tstep : cA; const char* nB = has_next ? (const char*)g.Bt + (size_t)nxt.pn * tstep : cB;
        for (int t = 0; t < nt; t += 2) {
            const bool last = (t == nt - 2);
            const char* a1 = cA + (size_t)(t + 1) * kstep;
            const char* a2 = last ? nA : cA + (size_t)(t + 2) * kstep; const char* b2 = last ? nB : cB + (size_t)(t + 2) * kstep;
            const char* a3 = a2 + kstep; const char* b3 = b2 + kstep;
            if (last && has_next) S.a_ready(nxt);
            if constexpr (SP2) {
            PG8_LDB(B0, 0, 0); PG8_LDB(B1, 0, 1); PG8_SCHED; PG8_LDA(At, 0, 0); PG8_STAGE(PG8_SA(1, 1), a1 + hstepA, voffA);
            PG8_WAIT_V(8); PG8_WAIT_L(0); PG8_BAR; PG8_MMA(0, 0, At, B0); PG8_MMA(0, 1, At, B1); PG8_BAR; PG8_SCHED;
            PG8_LDA(At, 0, 1); PG8_STAGE(PG8_SB(0, 0), b2, voffB); PG8_STAGE(PG8_SB(0, 1), b2 + hstep, voffB); PG8_STAGE(PG8_SA(0, 0), a2, voffA);
            PG8_WAIT_V(8); PG8_WAIT_L(0); PG8_BAR; PG8_MMA(1, 0, At, B0); PG8_MMA(1, 1, At, B1); PG8_BAR; PG8_SCHED;
            PG8_LDB(B0, 1, 0); PG8_LDB(B1, 1, 1); PG8_SCHED; PG8_LDA(At, 1, 0); PG8_STAGE(PG8_SA(0, 1), a2 + hstepA, voffA);
            PG8_WAIT_V(8); PG8_WAIT_L(0); PG8_BAR; PG8_MMA(0, 0, At, B0); PG8_MMA(0, 1, At, B1); PG8_BAR; PG8_SCHED;
            PG8_LDA(At, 1, 1); PG8_STAGE(PG8_SB(1, 0), b3, voffB); PG8_STAGE(PG8_SB(1, 1), b3 + hstep, voffB); PG8_STAGE(PG8_SA(1, 0), a3, voffA);
            PG8_WAIT_V(8); PG8_WAIT_L(0); PG8_BAR; PG8_MMA(1, 0, At, B0); PG8_MMA(1, 1, At, B1); PG8_BAR; PG8_SCHED;
            } else {
            PG8_LDB(B0, 0, 0); PG8_SCHED; PG8_LDA(At, 0, 0); PG8_STAGE(PG8_SA(1, 1), a1 + hstepA, voffA);
            PG8_WAIT_L(8); PG8_BAR; PG8_WAIT_L(0); PG8_MMA(0, 0, At, B0); PG8_BAR; PG8_SCHED;
            PG8_LDB(B1, 0, 1); PG8_STAGE(PG8_SB(0, 0), b2, voffB);
            PG8_BAR; PG8_WAIT_L(0); PG8_MMA(0, 1, At, B1); PG8_BAR;
            PG8_LDA(At, 0, 1); PG8_STAGE(PG8_SA(0, 0), a2, voffA);
            PG8_BAR; PG8_WAIT_L(0); PG8_MMA(1, 0, At, B0); PG8_BAR; PG8_SCHED;
            PG8_STAGE(PG8_SB(0, 1), b2 + hstep, voffB);
            PG8_WAIT_V(6); PG8_BAR; PG8_MMA(1, 1, At, B1); PG8_BAR;
            PG8_LDB(B0, 1, 0); PG8_SCHED; PG8_LDA(At, 1, 0); PG8_STAGE(PG8_SA(0, 1), a2 + hstepA, voffA);
            PG8_WAIT_L(8); PG8_BAR; PG8_WAIT_L(0); PG8_MMA(0, 0, At, B0); PG8_BAR; PG8_SCHED;
            PG8_LDB(B1, 1, 1); PG8_STAGE(PG8_SB(1, 0), b3, voffB);
            PG8_BAR; PG8_WAIT_L(0); PG8_MMA(0, 1, At, B1); PG8_BAR;
            PG8_LDA(At, 1, 1); PG8_STAGE(PG8_SA(1, 0), a3, voffA);
            PG8_BAR; PG8_WAIT_L(0); PG8_MMA(1, 0, At, B0); PG8_BAR; PG8_SCHED;
            PG8_STAGE(PG8_SB(1, 1), b3 + hstep, voffB);
            PG8_WAIT_V(6); PG8_BAR; PG8_MMA(1, 1, At, B1); PG8_BAR;
            }
        }
        if constexpr (ALIGN_EPI) { if (wr == 0) PG8_BAR; }
        if constexpr (!Epi::AFTER_DRAIN) { E(acc, cur, ui, wr, wc, fr, fq); S.done(cur); }
        if (!has_next) break;
#pragma unroll
        for (int a = 0; a < 2; ++a)
#pragma unroll
            for (int b = 0; b < 2; ++b)
#pragma unroll
                for (int m = 0; m < 4; ++m)
#pragma unroll
                    for (int n = 0; n < 2; ++n) acc[a][b][m][n] = (f32x4){0.f, 0.f, 0.f, 0.f};
        cur = nxt; cA = nA; cB = nB; ++ui;
        if constexpr (ALIGN_EPI) { if (wr == 1) PG8_BAR; }
    }
    PG8_WAIT_V(0);
    if constexpr (!ALIGN_EPI) { if (wr == 0) PG8_BAR; }
    PG8_BAR;
    static_assert(!Epi::AFTER_DRAIN, "no drained epilogues here");
#undef PG8_SA
#undef PG8_SB
#undef PG8_STAGE
#undef PG8_LDA
#undef PG8_LDB
#undef PG8_MMA
#undef PG8_WAIT_V
#undef PG8_WAIT_L
#undef PG8_BAR
#undef PG8_SCHED
}
}

#define LAS __attribute__((address_space(3)))
typedef unsigned short bf16;
typedef short s16x8 __attribute__((ext_vector_type(8)));
typedef short s16x4 __attribute__((ext_vector_type(4)));
typedef float f32x4 __attribute__((ext_vector_type(4)));
typedef float f32x16 __attribute__((ext_vector_type(16)));
typedef unsigned u32x4 __attribute__((ext_vector_type(4)));
typedef unsigned u32x2 __attribute__((ext_vector_type(2)));
typedef LAS unsigned char lbyte;

#ifndef WGM_UP
#define WGM_UP 4
#endif
#ifndef WGM_IN
#define WGM_IN 4
#endif
constexpr int NT = 512;
constexpr int D = 1024, BATCH = 4, SEQ = 8192, M = BATCH * SEQ, DFF = 2816, MEMLEN = 256, MROWS = BATCH * MEMLEN;
constexpr size_t MiB = 1u << 20;
constexpr size_t W_EV_IN = 0, W_EV_OUT = W_EV_IN + 2ull * 3072 * 1024, W_OD_IN = W_EV_OUT + 2ull * 1024 * 1024, W_OD_OUT = W_OD_IN + 2ull * 1280 * 1024,
                 W_CQ = W_OD_OUT + 2ull * 1024 * 1024, W_CKV = W_CQ + 4ull * 512 * 1024, W_CO = W_CKV + 4096ull * 1024, W_UP = W_CO + 4ull * 1024 * 512,
                 W_DN = W_UP + 4ull * 5632 * 1024, W_END = W_DN + 4ull * 1024 * 2816;
static_assert(W_END * 2 <= 108 * MiB, "weights fit");
constexpr size_t WS_W = 0, WS_XB = 108 * MiB, WS_QKV = 172 * MiB, WS_G = WS_QKV, WS_AO = 364 * MiB, WS_CQ = 428 * MiB, WS_CKV = 460 * MiB, WS_MEMB = 468 * MiB,
                 WS_SS = 470 * MiB, WS_SSM = 472 * MiB, WS_KM2 = 473 * MiB, WS_HALO = 474 * MiB, WS_CTL = 486 * MiB, CTL_BYTES = 65536, WS_END = 487 * MiB;
static_assert((size_t)M * 3072 * 2 <= WS_AO - WS_QKV && (size_t)M * DFF * 2 <= WS_AO - WS_QKV && (size_t)128 * 4 * 5632 * 4 <= WS_CTL - WS_HALO, "ws map");
constexpr int LDS_RING = 0, LDS_RTAB = 131072, LDS_EXCH = LDS_RTAB + 12288, LDS_BYTES = LDS_EXCH + 8192 + 1024;
constexpr int KP64 = 144;

struct Args { const float* in[25]; float* out; unsigned char* ws; int ph_lo, ph_hi; };

typedef float f32x2_t __attribute__((ext_vector_type(2))); typedef __bf16 bf16x2_t __attribute__((ext_vector_type(2)));
__device__ __forceinline__ unsigned pk2(float lo, float hi) { f32x2_t v = {lo, hi}; bf16x2_t b = __builtin_convertvector(v, bf16x2_t); return __builtin_bit_cast(unsigned, b); }
__device__ __forceinline__ float bf2f(unsigned short b) { return __builtin_bit_cast(float, (unsigned)b << 16); }
__device__ __forceinline__ float wave_sum(float v) {
#pragma unroll
    for (int o = 1; o < 64; o <<= 1) v += __shfl_xor(v, o);
    return v;
}
__device__ __forceinline__ float pair_max(float v) { auto r = __builtin_amdgcn_permlane32_swap(__float_as_uint(v), __float_as_uint(v), false, false); return fmaxf(__uint_as_float(r[0]), __uint_as_float(r[1])); }
__device__ __forceinline__ float pair_sum(float v) { auto r = __builtin_amdgcn_permlane32_swap(__float_as_uint(v), __float_as_uint(v), false, false); return __uint_as_float(r[0]) + __uint_as_float(r[1]); }
__device__ __forceinline__ float pair_other(float v, int h) { auto r = __builtin_amdgcn_permlane32_swap(__float_as_uint(v), __float_as_uint(v), false, false); return h ? __uint_as_float(r[0]) : __uint_as_float(r[1]); }

#define MFMA32(a, b, c) __builtin_amdgcn_mfma_f32_32x32x16_bf16(a, b, c, 0, 0, 0)
__device__ __forceinline__ int kkrow(int r, int h) { return 8 * (r >> 2) + 4 * h + (r & 3); }
__device__ __forceinline__ int t5_bucket(int d) {
    const int dc = d < 16 ? 16 : d;
    const int e = 31 - __clz(dc); const unsigned dd = (unsigned)dc * (unsigned)dc; const int half = dd >= (2u << (2 * e)) ? 1 : 0; int b = 2 * e + half + 8; b = b < 31 ? b : 31;
    return d < 16 ? d : b;
}
constexpr float LOG2E = 1.4426950408889634f;
template <int DCH> __device__ __forceinline__ f32x16 qk_sub(const lbyte* krows, int pitchB, const s16x8* qf, int l31, int h) {
    f32x16 s;
#pragma unroll
    for (int r = 0; r < 16; ++r) s[r] = 0.f;
    const lbyte* p = krows + l31 * pitchB + h * 16;
#pragma unroll
    for (int c = 0; c < DCH; ++c) { const s16x8 a = *(const LAS s16x8*)(p + c * 32); s = MFMA32(a, qf[c], s); }
    return s;
}
template <int DT> __device__ __forceinline__ void pv_sub(f32x16* o, const lbyte* vkeys, int vpitchB, s16x8 p0, s16x8 p1, int l31, int h) {
#pragma unroll
    for (int dt = 0; dt < DT; ++dt) { const lbyte* p = vkeys + (32 * dt + l31) * vpitchB + h * 8;
        const u32x2 a0 = *(const LAS u32x2*)(p), a1 = *(const LAS u32x2*)(p + 16), a2 = *(const LAS u32x2*)(p + 32), a3 = *(const LAS u32x2*)(p + 48);
        const s16x8 A0 = __builtin_bit_cast(s16x8, (u32x4){a0.x, a0.y, a1.x, a1.y}), A1 = __builtin_bit_cast(s16x8, (u32x4){a2.x, a2.y, a3.x, a3.y});
        o[dt] = MFMA32(A0, p0, o[dt]); o[dt] = MFMA32(A1, p1, o[dt]); }
}
__device__ __forceinline__ void pack_p(const f32x16& s, s16x8& p0, s16x8& p1) {
    u32x4 a, b; a.x = pk2(s[0], s[1]); a.y = pk2(s[2], s[3]); a.z = pk2(s[4], s[5]); a.w = pk2(s[6], s[7]); b.x = pk2(s[8], s[9]); b.y = pk2(s[10], s[11]); b.z = pk2(s[12], s[13]); b.w = pk2(s[14], s[15]);
    p0 = __builtin_bit_cast(s16x8, a); p1 = __builtin_bit_cast(s16x8, b);
}
template <int DCH> __device__ __forceinline__ void load_k(s16x8* kf, const lbyte* krows, int pitchB, int l31, int h) {
    const lbyte* p = krows + l31 * pitchB + h * 16;
#pragma unroll
    for (int c = 0; c < DCH; ++c) kf[c] = *(const LAS s16x8*)(p + c * 32);
}
template <int DT> __device__ __forceinline__ void load_v(s16x8* vf  , const lbyte* vkeys, int vpitchB, int l31, int h) {
#pragma unroll
    for (int dt = 0; dt < DT; ++dt) { const lbyte* p = vkeys + (32 * dt + l31) * vpitchB + h * 8;
        const u32x2 a0 = *(const LAS u32x2*)(p), a1 = *(const LAS u32x2*)(p + 16), a2 = *(const LAS u32x2*)(p + 32), a3 = *(const LAS u32x2*)(p + 48);
        vf[dt * 2 + 0] = __builtin_bit_cast(s16x8, (u32x4){a0.x, a0.y, a1.x, a1.y}); vf[dt * 2 + 1] = __builtin_bit_cast(s16x8, (u32x4){a2.x, a2.y, a3.x, a3.y}); }
}
template <int DCH> __device__ __forceinline__ void qk2(f32x16& s0, f32x16& s1, const s16x8* k0, const s16x8* k1, const s16x8* qf) {
#pragma unroll
    for (int r = 0; r < 16; ++r) { s0[r] = 0.f; s1[r] = 0.f; }
#pragma unroll
    for (int c = 0; c < DCH; ++c) { s0 = MFMA32(k0[c], qf[c], s0); s1 = MFMA32(k1[c], qf[c], s1); }
}
template <int DCH> __device__ __forceinline__ void qk1(f32x16& s0, const s16x8* k0, const s16x8* qf) {
#pragma unroll
    for (int r = 0; r < 16; ++r) s0[r] = 0.f;
#pragma unroll
    for (int c = 0; c < DCH; ++c) s0 = MFMA32(k0[c], qf[c], s0);
}
template <int DT> __device__ __forceinline__ void pv1(f32x16* o, const s16x8* vf, s16x8 p0, s16x8 p1) {
#pragma unroll
    for (int dt = 0; dt < DT; ++dt) o[dt] = MFMA32(vf[dt * 2], p0, o[dt]);
#pragma unroll
    for (int dt = 0; dt < DT; ++dt) o[dt] = MFMA32(vf[dt * 2 + 1], p1, o[dt]);
}
#define LDS_FENCE() asm volatile("" ::: "memory")
template <int NS, int DT> __device__ __forceinline__ void softmax_upd(f32x16* s, float& m, float& l, f32x16* o) {
    float mx = s[0][0];
#pragma unroll
    for (int i = 0; i < NS; ++i)
#pragma unroll
        for (int r = 0; r < 16; ++r) mx = fmaxf(mx, s[i][r]);
    mx = pair_max(mx);
    const bool grow = mx > m + 8.0f; const float mn = grow ? mx : m; float sum = 0.f;
    if (__any(grow)) { const float alpha = __builtin_amdgcn_exp2f(m - mn); l *= alpha;
#pragma unroll
        for (int dt = 0; dt < DT; ++dt) o[dt] = o[dt] * alpha; }
    m = mn;
#pragma unroll
    for (int i = 0; i < NS; ++i)
#pragma unroll
        for (int r = 0; r < 16; ++r) { const float e = __builtin_amdgcn_exp2f(s[i][r] - mn); s[i][r] = e; sum += e; }
    sum = pair_sum(sum);
    l += sum;
}
template <int DT> __device__ __forceinline__ void store_o(const f32x16* o, float inv, bf16* outrow, int h) {
#pragma unroll
    for (int dt = 0; dt < DT; ++dt)
#pragma unroll
        for (int g = 0; g < 4; g += 2) {
            unsigned ax = pk2(o[dt][4 * g] * inv, o[dt][4 * g + 1] * inv), ay = pk2(o[dt][4 * g + 2] * inv, o[dt][4 * g + 3] * inv);
            unsigned bx = pk2(o[dt][4 * g + 4] * inv, o[dt][4 * g + 5] * inv), by = pk2(o[dt][4 * g + 6] * inv, o[dt][4 * g + 7] * inv);
            { auto r = __builtin_amdgcn_permlane32_swap(ax, bx, false, false); ax = r[0]; bx = r[1]; }
            { auto r = __builtin_amdgcn_permlane32_swap(ay, by, false, false); ay = r[0]; by = r[1]; }
            *(u32x4*)(outrow + 32 * dt + 8 * g + 8 * h) = (u32x4){ax, ay, bx, by}; }
}
struct Stage64 { u32x4 k, v; };
__device__ __forceinline__ void stage_load(Stage64& st, const bf16* kt, const bf16* vt, int tid) {
    st.k = *(const u32x4*)(kt + tid * 8); st.v = *(const u32x4*)(vt + (tid & 63) * 64 + (tid >> 6) * 8);
}
__device__ __forceinline__ void stage_write(const Stage64& st, lbyte* kbuf, lbyte* vbuf, int tid) {
    *(LAS u32x4*)(kbuf + (tid >> 3) * KP64 + (tid & 7) * 16) = st.k;
    LAS unsigned short* vp = (LAS unsigned short*)(vbuf + ((tid >> 6) * 8) * KP64 + (tid & 63) * 2);
    vp[0 * (KP64 / 2)] = (unsigned short)(st.v.x & 0xffffu); vp[1 * (KP64 / 2)] = (unsigned short)(st.v.x >> 16);
    vp[2 * (KP64 / 2)] = (unsigned short)(st.v.y & 0xffffu); vp[3 * (KP64 / 2)] = (unsigned short)(st.v.y >> 16);
    vp[4 * (KP64 / 2)] = (unsigned short)(st.v.z & 0xffffu); vp[5 * (KP64 / 2)] = (unsigned short)(st.v.z >> 16);
    vp[6 * (KP64 / 2)] = (unsigned short)(st.v.w & 0xffffu); vp[7 * (KP64 / 2)] = (unsigned short)(st.v.w >> 16);
}
constexpr size_t EVSEG = (size_t)M * 512;

constexpr int EV_KB = 0, EV_VB = 36864, EV_KMEAN = 73728, EV_SELM = 81920, EV_TAB = 82944, EV_FLAG = 83072, EV_THR = 83136, EV_DTAB = 83264;
__device__ __forceinline__ void moba_unit(lbyte* lds, const bf16* QKV, bf16* AO, const float* km2, const float* rel_bias, int b, int hm, int own) {
    const int tid = pg8::opaque_tid(), wid = __builtin_amdgcn_readfirstlane(tid >> 6), lane = tid & 63, l31 = lane & 31, h = lane >> 5;
    const int ocol = (8 + hm) * 64; const size_t rowbase = (size_t)b * SEQ, hbase = ((size_t)(b * 8 + hm) * SEQ) * 64;
    const bf16* Qh = QKV + 3 * EVSEG + hbase; const bf16* Kh = QKV + 4 * EVSEG + hbase; const bf16* Vh = QKV + 5 * EVSEG + hbase;
    LAS float* kmean = (LAS float*)(lds + EV_KMEAN); LAS unsigned* selm = (LAS unsigned*)(lds + EV_SELM); LAS float* tab = (LAS float*)(lds + EV_TAB);
    for (int idx = tid; idx < own * 64; idx += NT) { const int n = idx >> 6, d = idx & 63; const size_t blk = (size_t)b * 32 + n;
        kmean[idx] = (km2[(blk * 2 + 0) * 512 + 64 * hm + d] + km2[(blk * 2 + 1) * 512 + 64 * hm + d]) * (1.0f / 256.0f); }
    LAS int* thr = (LAS int*)(lds + EV_THR);
    LAS float* dtab = (LAS float*)(lds + EV_DTAB);
    dtab[tid] = rel_bias[t5_bucket(tid) * 16 + 8 + hm] * LOG2E;
    if (tid < 32) { tab[tid] = rel_bias[tid * 16 + 8 + hm] * LOG2E;
        int tv = tid; if (tid >= 16) { const int eb = (tid - 8) >> 1; tv = ((tid - 8) & 1) ? (int)(1.41421356f * (float)(1 << eb)) + 1 : (1 << eb); } thr[tid] = tv; }
    __syncthreads();
    {
        const int qid = tid & 255, half = tid >> 8;
        float v0 = -3e38f, v1 = -3e38f, v2 = -3e38f; int i0 = -1, i1 = -1, i2 = -1;
        if (own > 0) {
            float q[64]; const bf16* qp = Qh + ((size_t)own * 256 + qid) * 64;
#pragma unroll
            for (int c = 0; c < 8; ++c) { const u32x4 w = *(const u32x4*)(qp + c * 8);
                q[c * 8 + 0] = __uint_as_float(w.x << 16); q[c * 8 + 1] = __uint_as_float(w.x & 0xffff0000u); q[c * 8 + 2] = __uint_as_float(w.y << 16); q[c * 8 + 3] = __uint_as_float(w.y & 0xffff0000u);
                q[c * 8 + 4] = __uint_as_float(w.z << 16); q[c * 8 + 5] = __uint_as_float(w.z & 0xffff0000u); q[c * 8 + 6] = __uint_as_float(w.w << 16); q[c * 8 + 7] = __uint_as_float(w.w & 0xffff0000u); }
            for (int n = half; n < own; n += 2) { float g = 0.f; const LAS float* kmn = kmean + n * 64;
#pragma unroll
                for (int d = 0; d < 64; d += 4) { const f32x4 kv = *(const LAS f32x4*)(kmn + d); g += q[d] * kv[0] + q[d + 1] * kv[1] + q[d + 2] * kv[2] + q[d + 3] * kv[3]; }
                if (g > v0) { v2 = v1; i2 = i1; v1 = v0; i1 = i0; v0 = g; i0 = n; } else if (g > v1) { v2 = v1; i2 = i1; v1 = g; i1 = n; } else if (g > v2) { v2 = g; i2 = n; } }
        }
        LAS float* cv = (LAS float*)(lds + EV_KB); LAS int* ci = (LAS int*)(lds + EV_KB + 4096);
        if (half == 1) { cv[qid * 3] = v0; cv[qid * 3 + 1] = v1; cv[qid * 3 + 2] = v2; ci[qid * 3] = i0; ci[qid * 3 + 1] = i1; ci[qid * 3 + 2] = i2; }
        __syncthreads();
        if (half == 0) {
#pragma unroll
            for (int k = 0; k < 3; ++k) { const float g = cv[qid * 3 + k]; const int n = ci[qid * 3 + k];
                if (n >= 0) {
                    if (g > v0 || (g == v0 && n < i0)) { v2 = v1; i2 = i1; v1 = v0; i1 = i0; v0 = g; i0 = n; }
                    else if (g > v1 || (g == v1 && n < i1)) { v2 = v1; i2 = i1; v1 = g; i1 = n; }
                    else if (g > v2 || (g == v2 && n < i2)) { v2 = g; i2 = n; } } }
            unsigned mask = 0u;
            if (i0 >= 0) mask |= 1u << i0; if (i1 >= 0) mask |= 1u << i1; if (i2 >= 0) mask |= 1u << i2;
            selm[qid] = mask;
        }
    }
    __syncthreads();
    const unsigned msel = selm[32 * wid + l31];
    const int qw0 = own * 256 + 32 * wid, tq = qw0 + l31;
    s16x8 qf[4];
#pragma unroll
    for (int c = 0; c < 4; ++c) qf[c] = *(const s16x8*)(Qh + (size_t)tq * 64 + 16 * c + 8 * h);
    f32x16 o[2];
#pragma unroll
    for (int r = 0; r < 16; ++r) { o[0][r] = 0.f; o[1][r] = 0.f; }
    float m = -1e30f, l = 0.f;
    const int ntile = 4 * own + 4;
    Stage64 ra, rb; stage_load(ra, Kh, Vh, tid); stage_load(rb, Kh + 4096, Vh + 4096, tid);
    stage_write(ra, lds + EV_KB, lds + EV_VB, tid); stage_write(rb, lds + EV_KB + 9216, lds + EV_VB + 9216, tid);
    __syncthreads();
#define MOBA_TILE(T, SLOT) { const int t = (T); \
        const int n = t >> 2, key0 = 64 * t; const bool ownblk = (n == own); \
        const bool lane_sel = ((msel >> n) & 1u) != 0u; \
        const bool active = ownblk ? (key0 <= qw0 + 31) : (__any(lane_sel) != 0); \
        if (active) { \
            const lbyte* kb = lds + EV_KB + (SLOT) * 9216; const lbyte* vb = lds + EV_VB + (SLOT) * 9216; \
            f32x16 s[2]; s16x8 kf0[4], kf1[4], vf0[4], vf1[4]; \
            load_k<4>(kf0, kb, KP64, l31, h); load_k<4>(kf1, kb + 32 * KP64, KP64, l31, h); LDS_FENCE(); \
            qk2<4>(s[0], s[1], kf0, kf1, qf); \
            const int dmin = qw0 - (key0 + 63), dmax = qw0 + 31 - key0; \
            const int bmin = t5_bucket(dmin > 0 ? dmin : 0), bmax = t5_bucket(dmax); \
            if (!ownblk && bmax - bmin <= 1) {               \
                  \
                const float t0 = tab[bmin], t1 = tab[bmax]; const int th1 = thr[bmax]; \
                const float d1 = t1 - t0, tmax = fmaxf(t0, t1); \
                float mxr = s[0][0]; \
                _Pragma("unroll") for (int i = 0; i < 2; ++i) \
                    _Pragma("unroll") for (int r = 0; r < 16; ++r) mxr = fmaxf(mxr, s[i][r]); \
                mxr = pair_max(mxr); \
                const float cL = lane_sel ? 0.125f * LOG2E : 0.f, bL = lane_sel ? t0 : -INFINITY; \
                const float mx = lane_sel ? mxr * (0.125f * LOG2E) + tmax : -INFINITY; \
                  \
                const bool grow = mx > m + 8.0f; const float mn = grow ? mx : m, off = bL - mn; f32x2_t sum2 = {0.f, 0.f}; \
                if (__any(grow)) { const float alpha = __builtin_amdgcn_exp2f(m - mn); l *= alpha; o[0] = o[0] * alpha; o[1] = o[1] * alpha; } \
                m = mn; \
                if (bmax == bmin) { \
                    const f32x2_t c2 = {cL, cL}, o2 = {off, off}; \
                    _Pragma("unroll") for (int i = 0; i < 2; ++i) \
                        _Pragma("unroll") for (int r = 0; r < 16; r += 2) { f32x2_t v = {s[i][r], s[i][r + 1]}; v = v * c2 + o2; \
                            const float e0 = __builtin_amdgcn_exp2f(v.x), e1 = __builtin_amdgcn_exp2f(v.y); s[i][r] = e0; s[i][r + 1] = e1; sum2 += (f32x2_t){e0, e1}; } \
                } else {                                   \
                    const int x1 = tq - key0 - th1; const float offB = off + d1; \
                    _Pragma("unroll") for (int i = 0; i < 2; ++i) \
                        _Pragma("unroll") for (int r = 0; r < 16; r += 2) { const int kk = 32 * i + kkrow(r, h); \
                            const f32x2_t ob = {x1 >= kk ? offB : off, x1 >= kk + 1 ? offB : off}; f32x2_t v = {s[i][r], s[i][r + 1]}; v = v * (f32x2_t){cL, cL} + ob; \
                            const float e0 = __builtin_amdgcn_exp2f(v.x), e1 = __builtin_amdgcn_exp2f(v.y); s[i][r] = e0; s[i][r + 1] = e1; sum2 += (f32x2_t){e0, e1}; } \
                } \
                float sum = sum2.x + sum2.y; \
                sum = pair_sum(sum); l += sum; \
            } else {                                         \
                _Pragma("unroll") for (int i = 0; i < 2; ++i) { float bb[16]; \
                    _Pragma("unroll") for (int r = 0; r < 16; ++r) { const int dist = tq - (key0 + 32 * i + kkrow(r, h)); bb[r] = dtab[dist > 0 ? dist : 0]; } \
                    LDS_FENCE(); \
                    _Pragma("unroll") for (int r = 0; r < 16; ++r) { const int dist = tq - (key0 + 32 * i + kkrow(r, h)); \
                        const bool ok = ownblk ? (dist >= 0) : lane_sel; s[i][r] = ok ? s[i][r] * (0.125f * LOG2E) + bb[r] : -INFINITY; } } \
                softmax_upd<2, 2>(s, m, l, o); \
            } \
            load_v<2>(vf0, vb, KP64, l31, h); load_v<2>(vf1, vb + 64, KP64, l31, h); LDS_FENCE(); \
            s16x8 p0, p1; pack_p(s[0], p0, p1); pv1<2>(o, vf0, p0, p1); \
            pack_p(s[1], p0, p1); pv1<2>(o, vf1, p0, p1); \
        } }
#pragma unroll 1
    for (int st = 0; 2 * st < ntile; ++st) { const int cur2 = (st & 1) * 2, t0 = 2 * st; const bool more = t0 + 2 < ntile;
        if (more) { stage_load(ra, Kh + (size_t)(t0 + 2) * 4096, Vh + (size_t)(t0 + 2) * 4096, tid); stage_load(rb, Kh + (size_t)(t0 + 3) * 4096, Vh + (size_t)(t0 + 3) * 4096, tid); }
        MOBA_TILE(t0, cur2) MOBA_TILE(t0 + 1, cur2 + 1)
        if (more) { stage_write(ra, lds + EV_KB + (cur2 ^ 2) * 9216, lds + EV_VB + (cur2 ^ 2) * 9216, tid); stage_write(rb, lds + EV_KB + ((cur2 ^ 2) + 1) * 9216, lds + EV_VB + ((cur2 ^ 2) + 1) * 9216, tid); }
        __syncthreads(); }
#undef MOBA_TILE
    store_o<2>(o, 1.0f / l, AO + (rowbase + tq) * 1024 + ocol, h);
}

typedef short v4i16_t __attribute__((ext_vector_type(4)));
constexpr int MC_VPR = 144;
template <int DT> __device__ __forceinline__ void load_v_tr(s16x8* vf  , const lbyte* vrows, int lane) {
    const int hh = lane >> 5, blk = (lane >> 4) & 1, q = (lane & 15) >> 2, p = lane & 3;
    const lbyte* base = vrows + (8 * hh + q) * MC_VPR + (16 * blk + 4 * p) * 2;
#pragma unroll
    for (int dt = 0; dt < DT; ++dt)
#pragma unroll
        for (int ks = 0; ks < 2; ++ks) {
            const v4i16_t a = __builtin_amdgcn_ds_read_tr16_b64_v4i16((LAS v4i16_t*)(base + (16 * ks) * MC_VPR + 64 * dt));
            const v4i16_t c = __builtin_amdgcn_ds_read_tr16_b64_v4i16((LAS v4i16_t*)(base + (16 * ks + 4) * MC_VPR + 64 * dt));
            vf[dt * 2 + ks] = (s16x8){a[0], a[1], a[2], a[3], c[0], c[1], c[2], c[3]}; }
}
__device__ __forceinline__ void pack_p_nat(const f32x16& s, s16x8& p0, s16x8& p1) {
    unsigned a0 = pk2(s[0], s[1]), a1 = pk2(s[2], s[3]), b0 = pk2(s[4], s[5]), b1 = pk2(s[6], s[7]);
    unsigned c0 = pk2(s[8], s[9]), c1 = pk2(s[10], s[11]), d0 = pk2(s[12], s[13]), d1 = pk2(s[14], s[15]);
    { auto r = __builtin_amdgcn_permlane32_swap(a0, b0, false, false); a0 = r[0]; b0 = r[1]; }
    { auto r = __builtin_amdgcn_permlane32_swap(a1, b1, false, false); a1 = r[0]; b1 = r[1]; }
    { auto r = __builtin_amdgcn_permlane32_swap(c0, d0, false, false); c0 = r[0]; d0 = r[1]; }
    { auto r = __builtin_amdgcn_permlane32_swap(c1, d1, false, false); c1 = r[0]; d1 = r[1]; }
    p0 = __builtin_bit_cast(s16x8, (u32x4){a0, a1, b0, b1}); p1 = __builtin_bit_cast(s16x8, (u32x4){c0, c1, d0, d1});
}
constexpr int MC_Q = 0, MC_WB = 36864, MC_WBSZ = 9216, MC_KMEAN = MC_WB + 8 * MC_WBSZ, MC_LIST = MC_KMEAN + 8192, MC_CNT = MC_LIST + 16384, MC_DTAB = MC_CNT + 512, MC_NDT = 2900, MC_TAB = MC_DTAB + MC_NDT * 4, MC_END = MC_TAB + 256;
static_assert(MC_END <= LDS_RTAB + 12288 + 8192, "compact MoBA LDS below the pointer table");
constexpr int PART_PITCH = 144, PART_SLAB = 256 * 3 * PART_PITCH;
struct Sub32 { u32x4 k[4], v[4]; };
__device__ __forceinline__ void sub_load(Sub32& r, const bf16* kt, const bf16* vt, int lane) {
#pragma unroll
    for (int i = 0; i < 4; ++i) { r.k[i] = *(const u32x4*)(kt + (i * 64 + lane) * 8); r.v[i] = *(const u32x4*)(vt + (i * 64 + lane) * 8); }
}
__device__ __forceinline__ void sub_write(const Sub32& r, lbyte* kbuf, lbyte* vbuf, int lane) {
#pragma unroll
    for (int i = 0; i < 4; ++i) { const int ci = i * 64 + lane; *(LAS u32x4*)(kbuf + (ci >> 3) * KP64 + (ci & 7) * 16) = r.k[i]; *(LAS u32x4*)(vbuf + (ci >> 3) * MC_VPR + (ci & 7) * 16) = r.v[i]; }
}
template <bool CAUSAL> __device__ __forceinline__ void moba_span(lbyte* kbuf, lbyte* vbuf, const bf16* Kh, const bf16* Vh, int kpos0, int nsub, const s16x8* qf, int tq, bool valid, int qlo, int qhi,
                                          const LAS float* dtab, const LAS float* tab, const LAS int* thr, float& m, float& l, f32x16* o, int lane, int l31, int h) {
    Sub32 st; sub_load(st, Kh + (size_t)kpos0 * 64, Vh + (size_t)kpos0 * 64, lane);
#pragma unroll 1
    for (int su = 0; su < nsub; ++su) {
        const int key0 = kpos0 + 32 * su;
        sub_write(st, kbuf, vbuf, lane);
        if (su + 1 < nsub) sub_load(st, Kh + (size_t)(key0 + 32) * 64, Vh + (size_t)(key0 + 32) * 64, lane);
        s16x8 kf[4], vf[4]; f32x16 s[1];
        load_k<4>(kf, kbuf, KP64, l31, h); load_v_tr<2>(vf, vbuf, lane); LDS_FENCE();
        qk1<4>(s[0], kf, qf);
        const int dmin = qlo - (key0 + 31), dmax = qhi - key0;
        const int bmin = t5_bucket(dmin > 0 ? dmin : 0), bmax = t5_bucket(dmax > 0 ? dmax : 0);
        if (!CAUSAL && bmax - bmin <= 1) {
            const float t0 = tab[bmin], t1 = tab[bmax]; const int th1 = thr[bmax];
            float mxr = s[0][0];
#pragma unroll
            for (int r = 1; r < 16; ++r) mxr = fmaxf(mxr, s[0][r]);
            mxr = pair_max(mxr);
            const float cL = valid ? 0.125f * LOG2E : 0.f, bL = valid ? t0 : -INFINITY, mx = valid ? mxr * (0.125f * LOG2E) + fmaxf(t0, t1) : -INFINITY;
            const bool grow = mx > m + 8.0f; const float mn = grow ? mx : m, off = bL - mn, offB = off + (t1 - t0);
            if (__any(grow)) { const float alpha = __builtin_amdgcn_exp2f(m - mn); l *= alpha; o[0] = o[0] * alpha; o[1] = o[1] * alpha; }
            m = mn;
            const int x1 = (bmax > bmin) ? tq - key0 - th1 : -0x40000000; f32x2_t sum2 = {0.f, 0.f};
#pragma unroll
            for (int r = 0; r < 16; r += 2) { const int kk = kkrow(r, h);
                const f32x2_t ob = {x1 >= kk ? offB : off, x1 >= kk + 1 ? offB : off}; f32x2_t v = {s[0][r], s[0][r + 1]}; v = v * (f32x2_t){cL, cL} + ob;
                const float e0 = __builtin_amdgcn_exp2f(v.x), e1 = __builtin_amdgcn_exp2f(v.y); s[0][r] = e0; s[0][r + 1] = e1; sum2 += (f32x2_t){e0, e1}; }
            l += pair_sum(sum2.x + sum2.y);
        } else {
            float bb[16];
#pragma unroll
            for (int r = 0; r < 16; ++r) { int dist = tq - (key0 + kkrow(r, h)); dist = dist > 0 ? dist : 0; bb[r] = dtab[dist < MC_NDT - 1 ? dist : MC_NDT - 1]; }
            LDS_FENCE();
#pragma unroll
            for (int r = 0; r < 16; ++r) { const int dist = tq - (key0 + kkrow(r, h)); const bool ok = valid && (!CAUSAL || dist >= 0); s[0][r] = ok ? s[0][r] * (0.125f * LOG2E) + bb[r] : -INFINITY; }
            softmax_upd<1, 2>(s, m, l, o);
        }
        s16x8 p0, p1; pack_p_nat(s[0], p0, p1); pv1<2>(o, vf, p0, p1);
    }
}
__device__ __forceinline__ void part_store(unsigned char* pp, const f32x16* o, float m, float l, int h) {
#pragma unroll
    for (int dt = 0; dt < 2; ++dt)
#pragma unroll
        for (int g = 0; g < 4; ++g) { u32x2 w; w.x = pk2(o[dt][4 * g], o[dt][4 * g + 1]); w.y = pk2(o[dt][4 * g + 2], o[dt][4 * g + 3]); *(u32x2*)(pp + (32 * dt + 8 * g + 4 * h) * 2) = w; }
    if (h == 0) { *(float*)(pp + 128) = m; *(float*)(pp + 132) = l; }
}
__device__ __forceinline__ void moba_unit2(lbyte* lds, const bf16* QKV, bf16* AO, unsigned char* part, unsigned char* part3, const float* km2, const float* rel_bias, int b, int hm, int own) {
    const int tid = pg8::opaque_tid(), wid = __builtin_amdgcn_readfirstlane(tid >> 6), lane = tid & 63, l31 = lane & 31, h = lane >> 5;
    const int ocol = (8 + hm) * 64; const size_t rowbase = (size_t)b * SEQ, hbase = ((size_t)(b * 8 + hm) * SEQ) * 64;
    const bf16* Qh = QKV + 3 * EVSEG + hbase; const bf16* Kh = QKV + 4 * EVSEG + hbase; const bf16* Vh = QKV + 5 * EVSEG + hbase;
    LAS float* kmean = (LAS float*)(lds + MC_KMEAN); LAS unsigned short* list = (LAS unsigned short*)(lds + MC_LIST); LAS unsigned* cnt = (LAS unsigned*)(lds + MC_CNT);
    LAS unsigned* istart = cnt + 32; LAS unsigned* ctr = cnt + 72; LAS float* dtab = (LAS float*)(lds + MC_DTAB); LAS float* tab = (LAS float*)(lds + MC_TAB); LAS int* thr = (LAS int*)(lds + MC_TAB + 128);
    lbyte* kbuf = lds + MC_WB + wid * MC_WBSZ; lbyte* vbuf = kbuf + 32 * KP64;
    for (int i = tid; i < 256 * 8; i += NT) { const int row = i >> 3, ch = i & 7; *(LAS u32x4*)(lds + MC_Q + row * KP64 + ch * 16) = *(const u32x4*)(Qh + ((size_t)own * 256 + row) * 64 + ch * 8); }
    for (int idx = tid; idx < own * 64; idx += NT) { const int n = idx >> 6, d = idx & 63; const size_t blk = (size_t)b * 32 + n;
        kmean[idx] = (km2[(blk * 2 + 0) * 512 + 64 * hm + d] + km2[(blk * 2 + 1) * 512 + 64 * hm + d]) * (1.0f / 256.0f); }
    if (tid < 32) { tab[tid] = rel_bias[tid * 16 + 8 + hm] * LOG2E;
        int tv = tid; if (tid >= 16) { const int eb = (tid - 8) >> 1; tv = ((tid - 8) & 1) ? (int)(1.41421356f * (float)(1 << eb)) + 1 : (1 << eb); } thr[tid] = tv; }
    if (tid < 80) cnt[tid] = 0u;
    __syncthreads();
    for (int i = tid; i < MC_NDT; i += NT) dtab[i] = tab[t5_bucket(i)];
    {
        const int qid = tid & 255, half = tid >> 8;
        float v0 = -3e38f, v1 = -3e38f, v2 = -3e38f; int i0 = -1, i1 = -1, i2 = -1;
        if (own > 0) {
            float q[64]; const lbyte* qp = lds + MC_Q + qid * KP64;
#pragma unroll
            for (int c = 0; c < 8; ++c) { const u32x4 w = *(const LAS u32x4*)(qp + c * 16);
                q[c * 8 + 0] = __uint_as_float(w.x << 16); q[c * 8 + 1] = __uint_as_float(w.x & 0xffff0000u); q[c * 8 + 2] = __uint_as_float(w.y << 16); q[c * 8 + 3] = __uint_as_float(w.y & 0xffff0000u);
                q[c * 8 + 4] = __uint_as_float(w.z << 16); q[c * 8 + 5] = __uint_as_float(w.z & 0xffff0000u); q[c * 8 + 6] = __uint_as_float(w.w << 16); q[c * 8 + 7] = __uint_as_float(w.w & 0xffff0000u); }
            for (int n = half; n < own; n += 2) { float g = 0.f; const LAS float* kmn = kmean + n * 64;
#pragma unroll
                for (int d = 0; d < 64; d += 4) { const f32x4 kv = *(const LAS f32x4*)(kmn + d); g += q[d] * kv[0] + q[d + 1] * kv[1] + q[d + 2] * kv[2] + q[d + 3] * kv[3]; }
                if (g > v0) { v2 = v1; i2 = i1; v1 = v0; i1 = i0; v0 = g; i0 = n; } else if (g > v1) { v2 = v1; i2 = i1; v1 = g; i1 = n; } else if (g > v2) { v2 = g; i2 = n; } }
        }
        LAS float* cv = (LAS float*)(lds + MC_WB); LAS int* ci = (LAS int*)(lds + MC_WB + 4096);
        if (half == 1) { cv[qid * 3] = v0; cv[qid * 3 + 1] = v1; cv[qid * 3 + 2] = v2; ci[qid * 3] = i0; ci[qid * 3 + 1] = i1; ci[qid * 3 + 2] = i2; }
        __syncthreads();
        if (half == 0 && own > 0) {
#pragma unroll
            for (int k = 0; k < 3; ++k) { const float g = cv[qid * 3 + k]; const int n = ci[qid * 3 + k];
                if (n >= 0) {
                    if (g > v0 || (g == v0 && n < i0)) { v2 = v1; i2 = i1; v1 = v0; i1 = i0; v0 = g; i0 = n; }
                    else if (g > v1 || (g == v1 && n < i1)) { v2 = v1; i2 = i1; v1 = g; i1 = n; }
                    else if (g > v2 || (g == v2 && n < i2)) { v2 = g; i2 = n; } } }
            if (i0 >= 0) { const unsigned p = __hip_atomic_fetch_add(cnt + i0, 1u, __ATOMIC_RELAXED, __HIP_MEMORY_SCOPE_WORKGROUP); list[i0 * 256 + p] = (unsigned short)(qid | (0 << 8)); }
            if (i1 >= 0) { const unsigned p = __hip_atomic_fetch_add(cnt + i1, 1u, __ATOMIC_RELAXED, __HIP_MEMORY_SCOPE_WORKGROUP); list[i1 * 256 + p] = (unsigned short)(qid | (1 << 8)); }
            if (i2 >= 0) { const unsigned p = __hip_atomic_fetch_add(cnt + i2, 1u, __ATOMIC_RELAXED, __HIP_MEMORY_SCOPE_WORKGROUP); list[i2 * 256 + p] = (unsigned short)(qid | (2 << 8)); }
        }
    }
    __syncthreads();
    LAS unsigned char* itemn = (LAS unsigned char*)(lds + MC_KMEAN);
    if (tid == 0) { unsigned acc = 0u; for (int n = 0; n < own; ++n) { istart[n] = acc; const unsigned cn = (cnt[n] + 31u) >> 5; for (unsigned k = 0; k < cn; ++k) itemn[acc + k] = (unsigned char)n; acc += cn; } istart[own] = acc; }
    __syncthreads();
    const unsigned total = istart[own];
    {
        const int qid = 32 * wid + l31, tq = own * 256 + qid;
        s16x8 qf[4];
#pragma unroll
        for (int cc = 0; cc < 4; ++cc) qf[cc] = *(const LAS s16x8*)(lds + MC_Q + qid * KP64 + (16 * cc + 8 * h) * 2);
        f32x16 o[2];
#pragma unroll
        for (int r = 0; r < 16; ++r) { o[0][r] = 0.f; o[1][r] = 0.f; }
        float m = -1e30f, l = 0.f;
        moba_span<true>(kbuf, vbuf, Kh, Vh, 256 * own, wid + 1, qf, tq, true, own * 256 + 32 * wid, own * 256 + 32 * wid + 31, dtab, tab, thr, m, l, o, lane, l31, h);
        part_store(part3 + (size_t)qid * PART_PITCH, o, m, l, h);
    }
    for (;;) {
        unsigned it = 0u; if (lane == 0) it = __hip_atomic_fetch_add(ctr, 1u, __ATOMIC_RELAXED, __HIP_MEMORY_SCOPE_WORKGROUP);
        it = (unsigned)__builtin_amdgcn_readfirstlane((int)it);
        if (it >= total) break;
        const int n = __builtin_amdgcn_readfirstlane((int)itemn[it]);
        const int c = (int)(it - istart[n]), idx = 32 * c + l31; const bool valid = idx < (int)cnt[n];
        const unsigned ent = list[n * 256 + (valid ? idx : 32 * c)]; const int qid = ent & 255, slot = ent >> 8, tq = own * 256 + qid;
        s16x8 qf[4];
#pragma unroll
        for (int cc = 0; cc < 4; ++cc) qf[cc] = *(const LAS s16x8*)(lds + MC_Q + qid * KP64 + (16 * cc + 8 * h) * 2);
        f32x16 o[2];
#pragma unroll
        for (int r = 0; r < 16; ++r) { o[0][r] = 0.f; o[1][r] = 0.f; }
        float m = -1e30f, l = 0.f;
        moba_span<false>(kbuf, vbuf, Kh, Vh, 256 * n, 8, qf, tq, valid, own * 256, own * 256 + 255, dtab, tab, thr, m, l, o, lane, l31, h);
        if (valid) part_store(part + (size_t)(qid * 3 + slot) * PART_PITCH, o, m, l, h);
    }
    __syncthreads();
    {
        const int qid = 32 * wid + l31, tq = own * 256 + qid; const int nsel = own < 3 ? own : 3;
        float m = -1e30f, l = 0.f; f32x16 o[2];
#pragma unroll
        for (int r = 0; r < 16; ++r) { o[0][r] = 0.f; o[1][r] = 0.f; }
        for (int sl = -1; sl < nsel; ++sl) { const unsigned char* pp = sl < 0 ? part3 + (size_t)qid * PART_PITCH : part + (size_t)(qid * 3 + sl) * PART_PITCH;
            const float ms = *(const float*)(pp + 128), ls = *(const float*)(pp + 132);
            const float mn = fmaxf(m, ms), a = __builtin_amdgcn_exp2f(m - mn), bq = __builtin_amdgcn_exp2f(ms - mn);
            l = l * a + ls * bq; m = mn;
#pragma unroll
            for (int dt = 0; dt < 2; ++dt)
#pragma unroll
                for (int g = 0; g < 4; ++g) { const u32x2 w = *(const u32x2*)(pp + (32 * dt + 8 * g + 4 * h) * 2);
                    o[dt][4 * g] = o[dt][4 * g] * a + __uint_as_float(w.x << 16) * bq; o[dt][4 * g + 1] = o[dt][4 * g + 1] * a + __uint_as_float(w.x & 0xffff0000u) * bq;
                    o[dt][4 * g + 2] = o[dt][4 * g + 2] * a + __uint_as_float(w.y << 16) * bq; o[dt][4 * g + 3] = o[dt][4 * g + 3] * a + __uint_as_float(w.y & 0xffff0000u) * bq; } }
        store_o<2>(o, 1.0f / l, AO + (rowbase + tq) * 1024 + ocol, h);
    }
}

__device__ __forceinline__ void sb_unit(lbyte* lds, const bf16* QKV, bf16* AO, int b, int h8, int qblk) {
    const int tid = pg8::opaque_tid(), wid = __builtin_amdgcn_readfirstlane(tid >> 6), lane = tid & 63, l31 = lane & 31, h = lane >> 5;
    const int ocol = 64 * h8; const size_t rowbase = (size_t)b * SEQ, hbase = ((size_t)(b * 8 + h8) * SEQ) * 64;
    const bf16* Qh = QKV + 0 * EVSEG + hbase; const bf16* Kh = QKV + 1 * EVSEG + hbase; const bf16* Vh = QKV + 2 * EVSEG + hbase;
    LAS unsigned* flag = (LAS unsigned*)(lds + EV_FLAG);
    const int qw0 = qblk * 256 + 32 * wid, tq = qw0 + l31;
    s16x8 qf[4];
#pragma unroll
    for (int c = 0; c < 4; ++c) qf[c] = *(const s16x8*)(Qh + (size_t)tq * 64 + 16 * c + 8 * h);
    f32x16 o[2];
#pragma unroll
    for (int r = 0; r < 16; ++r) { o[0][r] = 0.f; o[1][r] = 0.f; }
    float C = 0.f; bool done = false;
    const int tlast = 4 * qblk + 3;
    Stage64 ra, rb; stage_load(ra, Kh + (size_t)tlast * 4096, Vh + (size_t)tlast * 4096, tid); stage_write(ra, lds + EV_KB, lds + EV_VB, tid);
    stage_load(ra, Kh + (size_t)(tlast - 1) * 4096, Vh + (size_t)(tlast - 1) * 4096, tid);
    __syncthreads();
    bool fin = false;
#define SB_STEP(IT, RCUR, RNXT) if (!fin) { const int it = (IT), t = tlast - it, cur = it & 1; \
        if (t >= 2) stage_load(RNXT, Kh + (size_t)(t - 2) * 4096, Vh + (size_t)(t - 2) * 4096, tid); \
        if (!done && 64 * t <= qw0 + 30) { \
            const lbyte* kb = lds + EV_KB + cur * 9216; const lbyte* vb = lds + EV_VB + cur * 9216; \
            s16x8 kfs[2][4], vfs[2][4]; f32x16 ss[2]; \
            load_k<4>(kfs[0], kb, KP64, l31, h); load_k<4>(kfs[1], kb + 32 * KP64, KP64, l31, h); load_v<2>(vfs[0], vb, KP64, l31, h); load_v<2>(vfs[1], vb + 64, KP64, l31, h); LDS_FENCE(); \
            qk2<4>(ss[0], ss[1], kfs[0], kfs[1], qf); \
            _Pragma("unroll") for (int sub = 1; sub >= 0; --sub) { \
                const int kmin = 64 * t + 32 * sub; \
                if (kmin <= qw0 + 30) { \
                    f32x16 s = ss[sub]; \
                    float ln[16]; \
                      \
                    _Pragma("unroll") for (int r = 0; r < 16; ++r) { const float z = s[r] * (0.125f * LOG2E); const bool valid = (kmin + kkrow(r, h)) < tq; \
                        const float e = __builtin_amdgcn_exp2f(-fabsf(z)); const float sp = fmaxf(z, 0.f) + __builtin_amdgcn_logf(1.0f + e); \
                        ln[r] = valid ? -sp : 0.f; s[r] = valid ? (z - sp) : -INFINITY; } \
                    float run = 0.f; \
                    _Pragma("unroll") for (int g = 3; g >= 0; --g) { const float G = (ln[4 * g] + ln[4 * g + 1]) + (ln[4 * g + 2] + ln[4 * g + 3]); const float P = pair_other(G, h); \
                        const float b3 = C + run + (h == 0 ? P : 0.f), b2 = b3 + ln[4 * g + 3], b1 = b2 + ln[4 * g + 2], b0 = b1 + ln[4 * g + 1]; \
                        s[4 * g + 3] = __builtin_amdgcn_exp2f(s[4 * g + 3] + b3); s[4 * g + 2] = __builtin_amdgcn_exp2f(s[4 * g + 2] + b2); s[4 * g + 1] = __builtin_amdgcn_exp2f(s[4 * g + 1] + b1); s[4 * g] = __builtin_amdgcn_exp2f(s[4 * g] + b0); \
                        run += G + P; } \
                    C += run; \
                    s16x8 p0, p1; pack_p(s, p0, p1); pv1<2>(o, vfs[sub], p0, p1); \
                } \
            } \
            done = __all(C < -127.0f) != 0;        \
        } \
        if (lane == 0) flag[cur * 8 + wid] = done ? 1u : 0u;        \
        if (t >= 1) stage_write(RCUR, lds + EV_KB + (cur ^ 1) * 9216, lds + EV_VB + (cur ^ 1) * 9216, tid); \
        __syncthreads(); \
        if (t == 0) fin = true; \
        else { bool alld = true; \
            _Pragma("unroll") for (int w = 0; w < 8; ++w) alld = alld && (flag[cur * 8 + w] != 0u); \
            if (alld) fin = true; } }
#pragma unroll 1
    for (int it2 = 0; !fin; it2 += 2) { SB_STEP(it2, ra, rb) SB_STEP(it2 + 1, rb, ra) }
#undef SB_STEP
    store_o<2>(o, 1.0f, AO + (rowbase + tq) * 1024 + ocol, h);
}

__device__ __forceinline__ void sb_unit2(lbyte* lds, const bf16* QKV, bf16* AO, int b, int h8, int qblk) {
    const int tid = pg8::opaque_tid(), wid = __builtin_amdgcn_readfirstlane(tid >> 6), lane = tid & 63, l31 = lane & 31, h = lane >> 5;
    const int ocol = 64 * h8; const size_t rowbase = (size_t)b * SEQ, hbase = ((size_t)(b * 8 + h8) * SEQ) * 64;
    const bf16* Qh = QKV + 0 * EVSEG + hbase; const bf16* Kh = QKV + 1 * EVSEG + hbase; const bf16* Vh = QKV + 2 * EVSEG + hbase;
    lbyte* kbuf = lds + MC_WB + wid * MC_WBSZ; lbyte* vbuf = kbuf + 32 * KP64;
    const int qw0 = qblk * 256 + 32 * wid, tq = qw0 + l31;
    s16x8 qf[4];
#pragma unroll
    for (int c = 0; c < 4; ++c) qf[c] = *(const s16x8*)(Qh + (size_t)tq * 64 + 16 * c + 8 * h);
    f32x16 o[2];
#pragma unroll
    for (int r = 0; r < 16; ++r) { o[0][r] = 0.f; o[1][r] = 0.f; }
    float C = 0.f;
    int su = qw0 >> 5;
    Sub32 st; sub_load(st, Kh + (size_t)su * 2048, Vh + (size_t)su * 2048, lane);
#pragma unroll 1
    for (; su >= 0; --su) {
        const int kmin = 32 * su;
        sub_write(st, kbuf, vbuf, lane);
        if (su > 0) sub_load(st, Kh + (size_t)(su - 1) * 2048, Vh + (size_t)(su - 1) * 2048, lane);
        s16x8 kf[4], vf[4]; f32x16 s;
        load_k<4>(kf, kbuf, KP64, l31, h); load_v_tr<2>(vf, vbuf, lane); LDS_FENCE();
        qk1<4>(s, kf, qf);
        float ln[16];
#pragma unroll
        for (int r = 0; r < 16; ++r) { const float z = s[r] * (0.125f * LOG2E); const bool valid = (kmin + kkrow(r, h)) < tq;
            const float e = __builtin_amdgcn_exp2f(-fabsf(z)); const float sp = fmaxf(z, 0.f) + __builtin_amdgcn_logf(1.0f + e);
            ln[r] = valid ? -sp : 0.f; s[r] = valid ? (z - sp) : -INFINITY; }
        float run = 0.f;
#pragma unroll
        for (int g = 3; g >= 0; --g) { const float G = (ln[4 * g] + ln[4 * g + 1]) + (ln[4 * g + 2] + ln[4 * g + 3]); const float P = pair_other(G, h);
            const float b3 = C + run + (h == 0 ? P : 0.f), b2 = b3 + ln[4 * g + 3], b1 = b2 + ln[4 * g + 2], b0 = b1 + ln[4 * g + 1];
            s[4 * g + 3] = __builtin_amdgcn_exp2f(s[4 * g + 3] + b3); s[4 * g + 2] = __builtin_amdgcn_exp2f(s[4 * g + 2] + b2); s[4 * g + 1] = __builtin_amdgcn_exp2f(s[4 * g + 1] + b1); s[4 * g] = __builtin_amdgcn_exp2f(s[4 * g] + b0);
            run += G + P; }
        C += run;
        s16x8 p0, p1; pack_p_nat(s, p0, p1); pv1<2>(o, vf, p0, p1);
        if (__all(C < -127.0f)) break;
    }
    store_o<2>(o, 1.0f, AO + (rowbase + tq) * 1024 + ocol, h);
}

constexpr int SW_K = 0, SW_V = 27648, SW_VP = 400  , SW_BT = SW_V + 64 * SW_VP, SW_END = SW_BT + 8 * 320 * 4;
__device__ __forceinline__ void swa_unit(lbyte* lds, const bf16* QKV, bf16* AO, const float* rel_bias, const float* sinks, int b, int hkv, int qb) {
    const int tid = pg8::opaque_tid(), wid = __builtin_amdgcn_readfirstlane(tid >> 6), lane = tid & 63, l31 = lane & 31, h = lane >> 5;
    constexpr int LD = 1280; const int hq = 8 * hkv + wid, qcol = 64 * hq, kcol = 1024 + 64 * hkv, vcol = 1152 + 64 * hkv;
    const size_t rowbase = (size_t)b * SEQ; const int q0 = 64 * qb, k0 = q0 - 128;
    LAS float* bt = (LAS float*)(lds + SW_BT);
#pragma unroll
    for (int i = tid; i < 192 * 8; i += NT) { const int row = i >> 3, ch = i & 7, key = k0 + row; u32x4 kv = (u32x4){0u, 0u, 0u, 0u}, vv = kv;
        if (key >= 0) { kv = *(const u32x4*)(QKV + (rowbase + key) * LD + kcol + ch * 8); vv = *(const u32x4*)(QKV + (rowbase + key) * LD + vcol + ch * 8); }
        *(LAS u32x4*)(lds + SW_K + row * KP64 + ch * 16) = kv;
        LAS unsigned short* vp = (LAS unsigned short*)(lds + SW_V + (ch * 8) * SW_VP + row * 2);
        vp[0 * (SW_VP / 2)] = (unsigned short)(vv.x & 0xffffu); vp[1 * (SW_VP / 2)] = (unsigned short)(vv.x >> 16); vp[2 * (SW_VP / 2)] = (unsigned short)(vv.y & 0xffffu); vp[3 * (SW_VP / 2)] = (unsigned short)(vv.y >> 16);
        vp[4 * (SW_VP / 2)] = (unsigned short)(vv.z & 0xffffu); vp[5 * (SW_VP / 2)] = (unsigned short)(vv.z >> 16); vp[6 * (SW_VP / 2)] = (unsigned short)(vv.w & 0xffffu); vp[7 * (SW_VP / 2)] = (unsigned short)(vv.w >> 16); }
#pragma unroll
    for (int i = tid; i < 8 * 320; i += NT) { const int w = i / 320, dist = i % 320 - 64; bt[i] = (dist >= 0 && dist < 128) ? rel_bias[t5_bucket(dist > 0 ? dist : 0) * 16 + 8 * hkv + w] * LOG2E : -INFINITY; }
    __syncthreads();
    const float sink = sinks[hq];
#pragma unroll 1
    for (int c = 0; c < 2; ++c) {
        const int qs = q0 + 32 * c, tq = qs + l31;
        s16x8 qf[4];
#pragma unroll
        for (int cc = 0; cc < 4; ++cc) qf[cc] = *(const s16x8*)(QKV + (rowbase + tq) * LD + qcol + 16 * cc + 8 * h);
        f32x16 o[2];
#pragma unroll
        for (int r = 0; r < 16; ++r) { o[0][r] = 0.f; o[1][r] = 0.f; }
        float m = -1e30f, l = 0.f;
#pragma unroll 1
        for (int j = 0; j < 6; ++j) { const int ks = k0 + 32 * j;
            if (ks > qs + 31 || ks + 31 < qs - 127 || ks + 31 < 0) continue;
            f32x16 s[1]; s16x8 kf[4], vf[4]; load_k<4>(kf, lds + SW_K + 32 * j * KP64, KP64, l31, h); load_v<2>(vf, lds + SW_V + 64 * j, SW_VP, l31, h); LDS_FENCE(); qk1<4>(s[0], kf, qf);
#pragma unroll
            for (int r = 0; r < 16; ++r) { const int key = ks + kkrow(r, h), dist = tq - key; const float bias = bt[wid * 320 + dist + 64]; s[0][r] = key >= 0 ? s[0][r] * (0.125f * LOG2E) + bias : -INFINITY; }
            softmax_upd<1, 2>(s, m, l, o);
            s16x8 p0, p1; pack_p(s[0], p0, p1); pv1<2>(o, vf, p0, p1);
        }
        store_o<2>(o, 1.0f / (l + __builtin_amdgcn_exp2f(sink * LOG2E - m)), AO + (rowbase + tq) * 1024 + qcol, h);
    }
}

constexpr int CX_KP = 272, CX_VP = 528, CX_K = 0, CX_V = 256 * CX_KP, CX_END = CX_V + 128 * CX_VP;
static_assert(CX_END <= LDS_BYTES && SW_END <= LDS_BYTES, "attention LDS");
__device__ __forceinline__ void cross_unit(lbyte* lds, bf16* CQ, const bf16* CKV, const float* gq, const float* gk, int layer, int b, int hc, int qblk0, int qstep, int nq) {
    const int tid = pg8::opaque_tid(), wid = __builtin_amdgcn_readfirstlane(tid >> 6), lane = tid & 63, l31 = lane & 31, h = lane >> 5;
    constexpr int LDK = 4096; const int kcol = layer * 1024 + hc * 128, vcol = kcol + 512;
#pragma unroll 4
    for (int i = tid; i < 256 * 16; i += NT) { const int row = i >> 4, ch = i & 15; const bf16* src = CKV + (size_t)(b * MEMLEN + row) * LDK;
        const u32x4 kv = *(const u32x4*)(src + kcol + ch * 8), vv = *(const u32x4*)(src + vcol + ch * 8);
        { float f[8]; f[0] = __uint_as_float(kv.x << 16); f[1] = __uint_as_float(kv.x & 0xffff0000u); f[2] = __uint_as_float(kv.y << 16); f[3] = __uint_as_float(kv.y & 0xffff0000u);
          f[4] = __uint_as_float(kv.z << 16); f[5] = __uint_as_float(kv.z & 0xffff0000u); f[6] = __uint_as_float(kv.w << 16); f[7] = __uint_as_float(kv.w & 0xffff0000u);
          float ss = (f[0] * f[0] + f[1] * f[1]) + (f[2] * f[2] + f[3] * f[3]) + (f[4] * f[4] + f[5] * f[5]) + (f[6] * f[6] + f[7] * f[7]);
          ss = pg8::row16_sum(ss); const float rn = __builtin_amdgcn_rsqf(ss * (1.0f / 128.0f) + 1e-6f);
          const f32x4 ga = *(const f32x4*)(gk + ch * 8), gb = *(const f32x4*)(gk + ch * 8 + 4);
          u32x4 kn; kn.x = pk2(f[0] * rn * ga[0], f[1] * rn * ga[1]); kn.y = pk2(f[2] * rn * ga[2], f[3] * rn * ga[3]); kn.z = pk2(f[4] * rn * gb[0], f[5] * rn * gb[1]); kn.w = pk2(f[6] * rn * gb[2], f[7] * rn * gb[3]);
          *(LAS u32x4*)(lds + CX_K + row * CX_KP + ch * 16) = kn; }
        LAS unsigned short* vp = (LAS unsigned short*)(lds + CX_V + (ch * 8) * CX_VP + row * 2);
        vp[0 * (CX_VP / 2)] = (unsigned short)(vv.x & 0xffffu); vp[1 * (CX_VP / 2)] = (unsigned short)(vv.x >> 16); vp[2 * (CX_VP / 2)] = (unsigned short)(vv.y & 0xffffu); vp[3 * (CX_VP / 2)] = (unsigned short)(vv.y >> 16);
        vp[4 * (CX_VP / 2)] = (unsigned short)(vv.z & 0xffffu); vp[5 * (CX_VP / 2)] = (unsigned short)(vv.z >> 16); vp[6 * (CX_VP / 2)] = (unsigned short)(vv.w & 0xffffu); vp[7 * (CX_VP / 2)] = (unsigned short)(vv.w >> 16); }
    __syncthreads();
#pragma unroll 1
    for (int qi = 0; qi < nq; ++qi) { const int qblk = qblk0 + qi * qstep;
    const size_t row = (size_t)b * SEQ + qblk * 256 + 32 * wid + l31;
    bf16* qrow = CQ + row * 512 + hc * 128;
    s16x8 qf[8];
#pragma unroll
    for (int c = 0; c < 8; ++c) qf[c] = *(const s16x8*)(qrow + 16 * c + 8 * h);
    { float ss = 0.f;
#pragma unroll
      for (int c = 0; c < 8; ++c)
#pragma unroll
          for (int e2 = 0; e2 < 8; ++e2) { const float f = bf2f((unsigned short)qf[c][e2]); ss += f * f; }
      ss = pair_sum(ss); const float rn = __builtin_amdgcn_rsqf(ss * (1.0f / 128.0f) + 1e-6f);
#pragma unroll
      for (int c = 0; c < 8; ++c) { const f32x4 ga = *(const f32x4*)(gq + 16 * c + 8 * h), gb = *(const f32x4*)(gq + 16 * c + 8 * h + 4); u32x4 w;
          w.x = pk2(bf2f((unsigned short)qf[c][0]) * rn * ga[0], bf2f((unsigned short)qf[c][1]) * rn * ga[1]); w.y = pk2(bf2f((unsigned short)qf[c][2]) * rn * ga[2], bf2f((unsigned short)qf[c][3]) * rn * ga[3]);
          w.z = pk2(bf2f((unsigned short)qf[c][4]) * rn * gb[0], bf2f((unsigned short)qf[c][5]) * rn * gb[1]); w.w = pk2(bf2f((unsigned short)qf[c][6]) * rn * gb[2], bf2f((unsigned short)qf[c][7]) * rn * gb[3]);
          qf[c] = __builtin_bit_cast(s16x8, w); } }
    f32x16 o[4];
#pragma unroll
    for (int r = 0; r < 16; ++r) { o[0][r] = 0.f; o[1][r] = 0.f; o[2][r] = 0.f; o[3][r] = 0.f; }
    float m = -1e30f, l = 0.f; const float scale = 0.08838834764831845f * LOG2E;
#pragma unroll 1
    for (int t = 0; t < 8; ++t) {
        f32x16 s[1]; s16x8 kf[8], vf[8];
        load_k<8>(kf, lds + CX_K + (32 * t) * CX_KP, CX_KP, l31, h); load_v<4>(vf, lds + CX_V + 64 * t, CX_VP, l31, h); LDS_FENCE();
        qk1<8>(s[0], kf, qf);
#pragma unroll
        for (int r = 0; r < 16; ++r) s[0][r] *= scale;
        softmax_upd<1, 4>(s, m, l, o);
        s16x8 p0, p1; pack_p(s[0], p0, p1); pv1<4>(o, vf, p0, p1);
    }
    store_o<4>(o, 1.0f / l, qrow, h);
    }
}

__device__ __forceinline__ void conv_item(const float* W, int K, int N, bf16* WT, const float* gain, int mapmode, bool f16, LAS float* scr, int item, int lane) {
    const int nblk = N / 32, kb = item / nblk, nb = item % nblk, k0 = 64 * kb, n0 = 32 * nb;
#pragma unroll 16
    for (int i = 0; i < 32; ++i) { const int kk = 2 * i + (lane >> 5); float v = __builtin_nontemporal_load(W + (size_t)(k0 + kk) * N + n0 + (lane & 31)); if (gain) v *= gain[k0 + kk]; scr[kk * 33 + (lane & 31)] = v; }
    asm volatile("s_waitcnt lgkmcnt(0)" ::: "memory");
    const int c = lane & 7;
#pragma unroll
    for (int j = 0; j < 4; ++j) { const int nl = (lane >> 3) + 8 * j; int n = n0 + nl;
        if (mapmode == 1) { n = n < DFF ? (n / 128) * 256 + (n % 128) : ((n - DFF) / 128) * 256 + 128 + ((n - DFF) % 128); }
        const LAS float* s = scr + (8 * c) * 33 + nl;
        u32x4 o; if (f16) { o.x = pg8::pk2h(s[0 * 33], s[1 * 33]); o.y = pg8::pk2h(s[2 * 33], s[3 * 33]); o.z = pg8::pk2h(s[4 * 33], s[5 * 33]); o.w = pg8::pk2h(s[6 * 33], s[7 * 33]); }
        else { o.x = pk2(s[0 * 33], s[1 * 33]); o.y = pk2(s[2 * 33], s[3 * 33]); o.z = pk2(s[4 * 33], s[5 * 33]); o.w = pk2(s[6 * 33], s[7 * 33]); }
        *(u32x4*)(WT + (size_t)n * K + k0 + 8 * c) = o; }
    asm volatile("s_waitcnt lgkmcnt(0)" ::: "memory");
}
__device__ __forceinline__ void conv_weight(const float* W, int K, int N, bf16* WT, const float* gain, int mapmode, bool f16, LAS float* scr, int gw, int ngw, int& off, int lane) {
    const int nitems = (K / 64) * (N / 32);
    int first = (gw - off) % ngw; if (first < 0) first += ngw;
    for (int it = first; it < nitems; it += ngw) conv_item(W, K, N, WT, gain, mapmode, f16, scr, it, lane);
    off = (off + nitems) % ngw;
}
__device__ __forceinline__ void row_prep(const float* xrow, float* xcopy, bf16* brow, float* ss, bool f16, int lane) {
    const f32x4* xr = (const f32x4*)xrow + lane; f32x4 v[4]; float s = 0.f;
#pragma unroll
    for (int j = 0; j < 4; ++j) { v[j] = __builtin_nontemporal_load(xr + 64 * j); s += (v[j][0] * v[j][0] + v[j][1] * v[j][1]) + (v[j][2] * v[j][2] + v[j][3] * v[j][3]); }
    s = wave_sum(s);
#pragma unroll
    for (int j = 0; j < 4; ++j) { if (xcopy) ((f32x4*)xcopy + lane)[64 * j] = v[j]; u32x2 w; if (f16) { w.x = pg8::pk2h(v[j][0], v[j][1]); w.y = pg8::pk2h(v[j][2], v[j][3]); } else { w.x = pk2(v[j][0], v[j][1]); w.y = pk2(v[j][2], v[j][3]); } ((u32x2*)brow + lane)[64 * j] = w; }
    if (lane < 16) ss[lane] = lane == 0 ? s : 0.f;
}
template <class Sched> __device__ __forceinline__ void fill_rtab(LAS float* rtab, const Sched& S, const float* ss) {
    pg8::Unit u; const int tix = pg8::opaque_tid();
#pragma unroll 4
    for (int i = 0; S.next(i, u) && i < 12; ++i) { if (tix < 256) { const f32x4* p = (const f32x4*)(ss + (size_t)(u.pm * 256 + tix) * 16);
            const f32x4 a = p[0], b = p[1], c = p[2], d = p[3]; const float t = ((a[0] + a[1]) + (a[2] + a[3])) + ((b[0] + b[1]) + (b[2] + b[3])) + ((c[0] + c[1]) + (c[2] + c[3])) + ((d[0] + d[1]) + (d[2] + d[3]));
            rtab[i * 256 + tix] = __builtin_amdgcn_rsqf(t * (1.0f / 1024.0f) + 1e-6f); } }
    __syncthreads();
}

#define XB_TMO      128
#define XB_XCNT(j)  (256  + 64 * (j))
#define XB_XSUB(j)  (1280 + 64 * (j))
#define XB_XGEN(j)  (2304 + 64 * (j))
#define XB_TOP      3328
#define XB_TOPGEN   3392
#define XCD_BAR_WORDS 3456
#define XB_SPIN_CAP (1u << 18)

__device__ __forceinline__ unsigned xb_ld(unsigned* p)              { return __hip_atomic_load(p, __ATOMIC_RELAXED, __HIP_MEMORY_SCOPE_AGENT); }
__device__ __forceinline__ unsigned xb_add(unsigned* p, unsigned v) { return __hip_atomic_fetch_add(p, v, __ATOMIC_RELAXED, __HIP_MEMORY_SCOPE_AGENT); }
__device__ __forceinline__ unsigned xb_xcc_id() { return (unsigned)__builtin_amdgcn_s_getreg((3 << 11) | 20) & 0xFu; }
#define XB_SPIN(cond, bar) do { unsigned _sp = 0; while (cond) { __builtin_amdgcn_s_sleep(1); \
    if ((++_sp & 255u) == 0u) { if (xb_ld(&(bar)[XB_TMO])) break; if (_sp > XB_SPIN_CAP) { atomicAdd(&(bar)[XB_TMO], 1u); break; } } } } while (0)

struct XcdBarrier {
    unsigned* bar; unsigned x;
    volatile LAS unsigned* st;
};

__device__ __forceinline__ XcdBarrier xcd_barrier_post(unsigned* bar, volatile LAS unsigned* st) {
    XcdBarrier b; b.bar = bar; b.x = xb_xcc_id(); b.st = st;
    if (threadIdx.x == 0) (void)xb_add(&bar[XB_XCNT(b.x)], 1u);
    return b;
}
__device__ __forceinline__ void xcd_barrier_complete(unsigned* bar, unsigned x, unsigned& nloc, unsigned& nx) {
    const unsigned G = gridDim.x * gridDim.y * gridDim.z;
    unsigned sum, cnt, mine, sp = 0u;
    for (;;) {
        sum = 0u; cnt = 0u; mine = 0u;
#pragma unroll
        for (unsigned j = 0; j < 16; ++j) { const unsigned c = xb_ld(&bar[XB_XCNT(j)]); sum += c; cnt += (c > 0u) ? 1u : 0u; mine = (j == x) ? c : mine; }
        if (sum == G) break;
        __builtin_amdgcn_s_sleep(1);
        if ((++sp & 255u) == 0u) { if (xb_ld(&bar[XB_TMO])) break; if (sp > XB_SPIN_CAP) { atomicAdd(&bar[XB_TMO], 1u); break; } }
    }
    nloc = mine > 0u ? mine : 1u; nx = cnt > 0u ? cnt : 1u;
}

__device__ __forceinline__ void xcd_barrier(const XcdBarrier& b) {
    asm volatile("s_waitcnt vmcnt(0)" ::: "memory");
    __syncthreads();
    if (threadIdx.x == 0) {
        unsigned* bar = b.bar;
        __builtin_amdgcn_s_waitcnt(0);
        unsigned nloc = b.st[0], nx = b.st[1];
        if (nloc == 0u) { xcd_barrier_complete(bar, b.x, nloc, nx); b.st[0] = nloc; b.st[1] = nx; }
        const unsigned old = xb_add(&bar[XB_XSUB(b.x)], 1u);
        const unsigned gen = old / nloc;
        if (old + 1u == (gen + 1u) * nloc) {
            __builtin_amdgcn_fence(__ATOMIC_RELEASE, "agent");
            asm volatile("s_waitcnt vmcnt(0)" ::: "memory");
            const unsigned og = xb_add(&bar[XB_TOP], 1u);
            const unsigned tg = og / nx;
            if (og + 1u == (tg + 1u) * nx) xb_add(&bar[XB_TOPGEN], 1u);
            else XB_SPIN(xb_ld(&bar[XB_TOPGEN]) == tg, bar);
            __builtin_amdgcn_fence(__ATOMIC_ACQUIRE, "agent");
            xb_add(&bar[XB_XGEN(b.x)], 1u);
            asm volatile("s_waitcnt vmcnt(0)" ::: "memory");
        } else {
            XB_SPIN(xb_ld(&bar[XB_XGEN(b.x)]) == gen, bar);
            __builtin_amdgcn_fence(__ATOMIC_ACQUIRE, "agent");
            asm volatile("s_waitcnt vmcnt(0)" ::: "memory");
        }
    }
    __syncthreads();
}


constexpr int NPHASE = 1 + 4 * 8;
constexpr int LDS_PT = LDS_EXCH + 8192;
__device__ __forceinline__ unsigned long long ldptr(const LAS unsigned long long* P, int k) {
    const unsigned long long v = P[k]; const unsigned lo = __builtin_amdgcn_readfirstlane((unsigned)v), hi = __builtin_amdgcn_readfirstlane((unsigned)(v >> 32));
    return ((unsigned long long)hi << 32) | lo;
}
#define GASP __attribute__((address_space(1)))
#define INP(k) ((const float*)(const GASP float*)ldptr(PT, (k)))
#define OUTP ((float*)(GASP float*)ldptr(PT, 25))
#define WSP(T, off) ((T*)(GASP T*)(ldptr(PT, 26) + (off)))
__global__ void __launch_bounds__(NT, 2) trunk_fwd(Args args) {
    extern __shared__ __attribute__((aligned(16))) unsigned char lds_raw[];
    lbyte* lds = (lbyte*)lds_raw;
    cg::grid_group grid = cg::this_grid();
    const int tid = threadIdx.x, wave = __builtin_amdgcn_readfirstlane(tid >> 6), G = gridDim.x, bx = blockIdx.x;
    LAS unsigned long long* PT = (LAS unsigned long long*)(lds + LDS_PT);
    if (tid == 0) {
#pragma unroll
        for (int i = 0; i < 25; ++i) PT[i] = (unsigned long long)args.in[i];
        PT[25] = (unsigned long long)args.out; PT[26] = (unsigned long long)args.ws;
        ((LAS unsigned*)(lds + LDS_PT + 256))[0] = 0u; ((LAS unsigned*)(lds + LDS_PT + 256))[1] = 0u;
        (void)xb_add((unsigned*)(args.ws + WS_CTL) + XB_XCNT(xb_xcc_id()), 1u);
    }
    __syncthreads();
    LAS float* rtab = (LAS float*)(lds + LDS_RTAB); LAS float* exch = (LAS float*)(lds + LDS_EXCH);
    const int lo = args.ph_lo, hi = args.ph_hi;
#define IN(k) (lo <= (k) && (k) < hi)
#define SEAM(k) do { if (IN(k) && IN((k) + 1)) { if ((k) == 0) grid.sync(); else { XcdBarrier xb_; xb_.bar = WSP(unsigned, WS_CTL); xb_.x = xb_xcc_id(); xb_.st = (volatile LAS unsigned*)(lds + LDS_PT + 256); xcd_barrier(xb_); } } } while (0)

    if (IN(0)) {
        const int lane = pg8::opaque_tid() & 63;
        LAS float* scr = (LAS float*)(lds + wave * 8448);
        const int gw = bx * 8 + wave, ngw = G * 8; int off = 0;
        bf16* WB = WSP(bf16, WS_W);
        for (int i = 0; i < 2; ++i) {
            conv_weight(INP(4) + (size_t)i * 1024 * 3072, 1024, 3072, WB + W_EV_IN + (size_t)i * 3072 * 1024, INP(3) + (2 * i) * 1024, 0, RESID_F16 != 0, scr, gw, ngw, off, lane);
            conv_weight(INP(5) + (size_t)i * 1024 * 1024, 1024, 1024, WB + W_EV_OUT + (size_t)i * 1024 * 1024, nullptr, 0, false, scr, gw, ngw, off, lane);
            conv_weight(INP(8) + (size_t)i * 1024 * 1280, 1024, 1280, WB + W_OD_IN + (size_t)i * 1280 * 1024, INP(3) + (2 * i + 1) * 1024, 0, RESID_F16 != 0, scr, gw, ngw, off, lane);
            conv_weight(INP(9) + (size_t)i * 1024 * 1024, 1024, 1024, WB + W_OD_OUT + (size_t)i * 1024 * 1024, nullptr, 0, false, scr, gw, ngw, off, lane);
        }
        for (int l = 0; l < 4; ++l) {
            conv_weight(INP(15) + (size_t)l * 1024 * 512, 1024, 512, WB + W_CQ + (size_t)l * 512 * 1024, INP(13) + l * 1024, 0, RESID_F16 != 0, scr, gw, ngw, off, lane);
            conv_weight(INP(16) + (size_t)l * 1024 * 1024, 1024, 1024, WB + W_CKV + (size_t)l * 1024 * 1024, INP(14) + l * 1024, 0, false, scr, gw, ngw, off, lane);
            conv_weight(INP(17) + (size_t)l * 512 * 1024, 512, 1024, WB + W_CO + (size_t)l * 1024 * 512, nullptr, 0, false, scr, gw, ngw, off, lane);
            conv_weight(INP(21) + (size_t)l * 1024 * 5632, 1024, 5632, WB + W_UP + (size_t)l * 5632 * 1024, INP(20) + l * 1024, 1, RESID_F16 != 0, scr, gw, ngw, off, lane);
            conv_weight(INP(24) + (size_t)l * 2816 * 1024, 2816, 1024, WB + W_DN + (size_t)l * 1024 * 2816, nullptr, 0, false, scr, gw, ngw, off, lane);
        }
        { const float* xin = INP(0); bf16* XB = WSP(bf16, WS_XB); float* SS = WSP(float, WS_SS);
          for (int r = gw; r < M; r += ngw) row_prep(xin + (size_t)r * 1024, nullptr, XB + (size_t)r * 1024, SS + (size_t)r * 16, RESID_F16 != 0, lane); }
        { const float* min_ = INP(1); bf16* MEMB = WSP(bf16, WS_MEMB); float* SSM = WSP(float, WS_SSM);
          for (int r = gw; r < MROWS; r += ngw) row_prep(min_ + (size_t)r * 1024, nullptr, MEMB + (size_t)r * 1024, SSM + (size_t)r * 16, false, lane); }
        __syncthreads();
    }
    SEAM(0);

#pragma unroll 1
    for (int layer = 0; layer < 4; ++layer) {
        const int pb = 1 + 8 * layer, li = layer >> 1; const bool even = (layer & 1) == 0;
        if (IN(pb)) {
            if (layer == 0) {
                pg8::Gemm g{WSP(bf16, WS_MEMB), WSP(bf16, WS_W) + W_CKV, MROWS, 4096, 1024}; pg8::StaticOrder S; S.init(MROWS, 4096, G, bx);
                fill_rtab(rtab, S, WSP(float, WS_SSM));
                pg8::EpiProj<3> E{WSP(bf16, WS_CKV), 4096, rtab, exch, nullptr, INP(19), nullptr};
#ifndef SKIP_GEMM_EpiProj3
                pg8::gemm_phase<pg8::EpiProj<3>, pg8::StaticOrder, true, true>(lds + LDS_RING, g, S, E);
#endif
            }
            if (even) {
                pg8::Gemm g{WSP(bf16, WS_XB), WSP(bf16, WS_W) + W_EV_IN + (size_t)li * 3072 * 1024, M, 3072, 1024}; pg8::StaticOrder S; S.init(M, 3072, G, bx, WGM_IN);
                fill_rtab(rtab, S, WSP(float, WS_SS));
                pg8::EpiProj<0> E{WSP(bf16, WS_QKV), 3072, rtab, exch, INP(6) + li * 64, INP(7) + li * 64, WSP(float, WS_KM2)};
#ifndef SKIP_GEMM_EpiProj0
                pg8::gemm_phase<pg8::EpiProj<0>, pg8::StaticOrder, true, true>(lds + LDS_RING, g, S, E);
#endif
            } else {
                pg8::Gemm g{WSP(bf16, WS_XB), WSP(bf16, WS_W) + W_OD_IN + (size_t)li * 1280 * 1024, M, 1280, 1024}; pg8::StaticOrder S; S.init(M, 1280, G, bx);
                fill_rtab(rtab, S, WSP(float, WS_SS));
                pg8::EpiProj<1> E{WSP(bf16, WS_QKV), 1280, rtab, exch, INP(10) + li * 64, INP(11) + li * 64, nullptr};
#ifndef SKIP_GEMM_EpiProj1
                pg8::gemm_phase<pg8::EpiProj<1>, pg8::StaticOrder, true, true>(lds + LDS_RING, g, S, E);
#endif
            }
        }
        SEAM(pb);
#ifndef REP_ATTN
#define REP_ATTN 1
#endif
        if (IN(pb + 1)) for (int rep = 0; rep < (even ? REP_ATTN : 1); ++rep) {
            if (rep) grid.sync();
            if (even) {
                for (int u = bx; u < 2048; u += G) {
                    const int rnd = u / 256, w = u % 256, x = w % 8, j = w / 8, pr = 4 * x + (rnd & 3), b = pr / 8, hh = pr % 8;
                    if (rnd < 4) {
#ifndef SKIP_MOBA
#ifdef MOBA_DENSE
                        moba_unit(lds, WSP(bf16, WS_QKV), WSP(bf16, WS_AO), WSP(float, WS_KM2), INP(2), b, hh, (rnd & 1) ? j : 31 - j);
#else
                        moba_unit2(lds, WSP(bf16, WS_QKV), WSP(bf16, WS_AO), WSP(unsigned char, WS_CQ) + (size_t)bx * PART_SLAB, WSP(unsigned char, WS_HALO) + (size_t)bx * (256 * PART_PITCH), WSP(float, WS_KM2), INP(2), b, hh, (rnd & 1) ? j : 31 - j);
#endif
#endif
                    } else {
#ifndef SKIP_SB
#ifdef SB_SHARED
                        sb_unit(lds, WSP(bf16, WS_QKV), WSP(bf16, WS_AO), b, hh, j);
#else
                        sb_unit2(lds, WSP(bf16, WS_QKV), WSP(bf16, WS_AO), b, hh, j);
#endif
#endif
                    }
                    __syncthreads();
                }
            } else {
                for (int u = bx; u < 1024; u += G) { const int rem = u % 8, b = rem / 2, hkv = rem % 2, qb = u / 8;
#ifndef SKIP_SWA
                    swa_unit(lds, WSP(bf16, WS_QKV), WSP(bf16, WS_AO), INP(2), INP(12) + li * 16, b, hkv, qb);
#endif
                    __syncthreads(); }
            }
        }
        SEAM(pb + 1);
        if (IN(pb + 2)) {
            pg8::Gemm g{WSP(bf16, WS_AO), WSP(bf16, WS_W) + (even ? W_EV_OUT : W_OD_OUT) + (size_t)li * 1024 * 1024, M, 1024, 1024}; pg8::StaticOrder S; S.init(M, 1024, G, bx);
            pg8::EpiRes<false, false> E{nullptr, nullptr, WSP(bf16, WS_XB), WSP(float, WS_SS)};
#ifndef SKIP_GEMM_EpiRes
            pg8::gemm_phase<pg8::EpiRes<false, false>, pg8::StaticOrder, true, true>(lds + LDS_RING, g, S, E);
#endif
        }
        SEAM(pb + 2);
        if (IN(pb + 3)) {
            pg8::Gemm g{WSP(bf16, WS_XB), WSP(bf16, WS_W) + W_CQ + (size_t)layer * 512 * 1024, M, 512, 1024}; pg8::StaticOrder S; S.init(M, 512, G, bx);
            fill_rtab(rtab, S, WSP(float, WS_SS));
            pg8::EpiProj<2> E{WSP(bf16, WS_CQ), 512, rtab, exch, INP(18) + layer * 128, nullptr, nullptr};
#ifndef SKIP_GEMM_EpiProj2
            pg8::gemm_phase<pg8::EpiProj<2>, pg8::StaticOrder, true, true>(lds + LDS_RING, g, S, E);
#endif
        }
        SEAM(pb + 3);
        if (IN(pb + 4)) {
            if (G % 16 == 0) {
                const int rem = bx % 16, nq = (32 - bx / 16 + G / 16 - 1) / (G / 16);
#ifndef SKIP_CROSS
                if (bx / 16 < 32) cross_unit(lds, WSP(bf16, WS_CQ), WSP(bf16, WS_CKV), INP(18) + layer * 128, INP(19) + layer * 128, layer, rem / 4, rem % 4, bx / 16, G / 16, nq);
#endif
                __syncthreads();
            } else {
                for (int u = bx; u < 512; u += G) { const int rem = u % 16;
#ifndef SKIP_CROSS
                    cross_unit(lds, WSP(bf16, WS_CQ), WSP(bf16, WS_CKV), INP(18) + layer * 128, INP(19) + layer * 128, layer, rem / 4, rem % 4, u / 16, 0, 1);
#endif
                    __syncthreads(); }
            }
        }
        SEAM(pb + 4);
        if (IN(pb + 5)) {
            pg8::Gemm g{WSP(bf16, WS_CQ), WSP(bf16, WS_W) + W_CO + (size_t)layer * 1024 * 512, M, 1024, 512}; pg8::StaticOrder S; S.init(M, 1024, G, bx);
            pg8::EpiRes<false, false> E{nullptr, nullptr, WSP(bf16, WS_XB), WSP(float, WS_SS)};
#ifndef SKIP_GEMM_EpiRes
            pg8::gemm_phase<pg8::EpiRes<false, false>, pg8::StaticOrder, true, true>(lds + LDS_RING, g, S, E);
#endif
        }
        SEAM(pb + 5);
#ifndef REP_UP
#define REP_UP 1
#endif
        if (IN(pb + 6)) for (int rep = 0; rep < REP_UP; ++rep) {
            if (rep) grid.sync();
            pg8::Gemm g{WSP(bf16, WS_XB), WSP(bf16, WS_W) + W_UP + (size_t)layer * 5632 * 1024, M, 5632, 1024}; pg8::StaticOrder S; S.init(M, 5632, G, bx, WGM_UP);
            fill_rtab(rtab, S, WSP(float, WS_SS));
            pg8::EpiFfnUp E{WSP(bf16, WS_G), rtab, exch, INP(22) + (size_t)layer * 3 * 5632, INP(23) + (size_t)layer * 5632, WSP(float, WS_HALO)};
#ifndef SKIP_GEMM_EpiFfnUp
            pg8::gemm_phase<pg8::EpiFfnUp, pg8::StaticOrder, true, true>(lds + LDS_RING, g, S, E);
#endif
        }
        SEAM(pb + 6);
        if (IN(pb + 7)) {
            pg8::StaticOrder S; S.init(M, 1024, G, bx);
            { const float* cw = INP(22) + (size_t)layer * 3 * 5632; const float* cb = INP(23) + (size_t)layer * 5632; const float* HALO = WSP(float, WS_HALO); bf16* GB = WSP(bf16, WS_G);
            pg8::Unit u;
            for (int i = 0; S.next(i, u); ++i) {
                const bool first = (u.pm % 32) == 0;
                for (int f = pg8::opaque_tid(); f < DFF; f += NT) { float cg0[2], cg1[2];
#pragma unroll
                    for (int part = 0; part < 2; ++part) { const int ch = part * DFF + f;
                        const float um2 = first ? 0.f : HALO[(size_t)((u.pm - 1) * 4 + 2) * 5632 + ch], um1 = first ? 0.f : HALO[(size_t)((u.pm - 1) * 4 + 3) * 5632 + ch];
                        const float u0 = HALO[(size_t)(u.pm * 4 + 0) * 5632 + ch], u1 = HALO[(size_t)(u.pm * 4 + 1) * 5632 + ch];
                        const float w0 = cw[ch], w1 = cw[5632 + ch], w2 = cw[2 * 5632 + ch], bb = cb[ch];
                        cg0[part] = bb + w0 * um2 + w1 * um1 + w2 * u0; cg1[part] = bb + w0 * um1 + w1 * u0 + w2 * u1; }
                    const float g0 = cg0[0] / (1.0f + __expf(-cg0[0])) * cg0[1], g1 = cg1[0] / (1.0f + __expf(-cg1[0])) * cg1[1];
                    GB[(size_t)(u.pm * 256) * DFF + f] = (bf16)(pk2(g0, 0.f) & 0xffffu); GB[(size_t)(u.pm * 256 + 1) * DFF + f] = (bf16)(pk2(g1, 0.f) & 0xffffu); }
            } }
            __syncthreads();
            pg8::Gemm g{WSP(bf16, WS_G), WSP(bf16, WS_W) + W_DN + (size_t)layer * 1024 * 2816, M, 1024, 2816};
            if (layer == 3) { pg8::EpiRes<false, true> E{nullptr, OUTP, WSP(bf16, WS_XB), WSP(float, WS_SS)};
#ifndef SKIP_GEMM_EpiRes
                pg8::gemm_phase<pg8::EpiRes<false, true>, pg8::StaticOrder, true, true>(lds + LDS_RING, g, S, E);
#endif
            } else { pg8::EpiRes<false, false> E{nullptr, nullptr, WSP(bf16, WS_XB), WSP(float, WS_SS)};
#ifndef SKIP_GEMM_EpiRes
                pg8::gemm_phase<pg8::EpiRes<false, false>, pg8::StaticOrder, true, true>(lds + LDS_RING, g, S, E);
#endif
            }
        }
        SEAM(pb + 7);
    }
#undef IN
#undef SEAM
}

#ifndef MK_SPLIT
#define MK_SPLIT 0
#endif
extern "C" void kernel_launch(void* const* d_in, const int* in_sizes, int n_in, void* d_out, int out_size, void* d_ws, size_t ws_size, hipStream_t stream) {
    static int grid = 0;
    if (grid == 0) {
        if (n_in != 25 || out_size != M * D || ws_size < WS_END) { fprintf(stderr, "kernel_launch: unexpected shapes (n_in %d out %d ws %zu)\n", n_in, out_size, ws_size); grid = -1; return; }
        int dev = 0, cus = 0, per_cu = 0;
        hipGetDevice(&dev); hipDeviceGetAttribute(&cus, hipDeviceAttributeMultiprocessorCount, dev);
        if (hipFuncSetAttribute((const void*)trunk_fwd, hipFuncAttributeMaxDynamicSharedMemorySize, LDS_BYTES) != hipSuccess) { fprintf(stderr, "kernel_launch: hipFuncSetAttribute failed\n"); }
        if (hipOccupancyMaxActiveBlocksPerMultiprocessor(&per_cu, (const void*)trunk_fwd, NT, LDS_BYTES) != hipSuccess || per_cu < 1) { fprintf(stderr, "kernel_launch: occupancy query says %d\n", per_cu); per_cu = 1; }
        (void)hipGetLastError();
        grid = cus * (per_cu > 1 ? 1 : per_cu);
    }
    if (grid < 0) return;
    if (hipMemsetAsync((char*)d_ws + WS_CTL, 0, CTL_BYTES, stream) != hipSuccess) { fprintf(stderr, "kernel_launch: memset failed\n"); return; }
    Args a{};
    for (int i = 0; i < 25; ++i) a.in[i] = (const float*)d_in[i];
    a.out = (float*)d_out; a.ws = (unsigned char*)d_ws;
#if MK_SPLIT
    for (int p = 0; p < NPHASE; ++p) { a.ph_lo = p; a.ph_hi = p + 1; void* kargs[] = {&a};
        hipError_t e = hipLaunchCooperativeKernel((const void*)trunk_fwd, dim3(grid), dim3(NT), kargs, LDS_BYTES, stream);
        if (e != hipSuccess) { fprintf(stderr, "launch %d failed: %s\n", p, hipGetErrorString(e)); break; } }
#else
    a.ph_lo = 0; a.ph_hi = NPHASE; void* kargs[] = {&a};
    hipError_t e = hipLaunchCooperativeKernel((const void*)trunk_fwd, dim3(grid), dim3(NT), kargs, LDS_BYTES, stream);
    if (e != hipSuccess) fprintf(stderr, "cooperative launch failed: %s (grid %d)\n", hipGetErrorString(e), grid);
#endif
}
```

```cpp
#include <hip/hip_runtime.h>
#include <hip/hip_cooperative_groups.h>
#include <cstdio>
#include <cstdint>
#include <cmath>
namespace cg = cooperative_groups;
namespace pg8 {
#define PG8_LAS __attribute__((address_space(3)))
typedef unsigned short bf16_t;
typedef short bf16x8 __attribute__((ext_vector_type(8)));
typedef float f32x4 __attribute__((ext_vector_type(4)));
typedef unsigned u32x4 __attribute__((ext_vector_type(4)));
constexpr int BM = 256, BK = 64, HALF = 128, HTB = HALF * BK * 2  , STAGE_BYTES = 8 * HTB, NXCD = 8, WGM = 4;

__host__ __device__ __forceinline__ int lds_byte(int r, int c) { const int st = (r >> 4) * 2 + (c >> 5), rr = r & 15, cc = c & 31, ob = rr * 64 + cc * 2; return st * 1024 + (ob ^ (((ob >> 9) & 1) << 5)); }
__host__ __device__ __forceinline__ void stage_rc(int b, int& R, int& C) { const int st = b / 1024, sb = b % 1024, swz = sb ^ (((sb >> 9) & 1) << 5); R = (st >> 1) * 16 + swz / 64; C = (st & 1) * 32 + (swz % 64) / 2; }
__host__ __device__ __forceinline__ int perm32(int rho) { const int n = rho >> 4, i = rho & 15; return 8 * (i >> 2) + 4 * n + (i & 3); }

struct Unit { int pm, pn; };
struct Gemm { const bf16_t* A; const bf16_t* Bt; int M, N, K; };

struct StaticOrder {
    int nM, nN, nwg, G, c, wgm;
    __host__ __device__ void init(int M, int N, int G_, int c_, int wgm_ = WGM) { nM = M / BM; nN = N / BM; nwg = nM * nN; G = G_; c = c_; wgm = wgm_; }
    __host__ __device__ bool next(int i, Unit& u) const {
        const long L = (long)i * G + c; if (L >= nwg) return false;
        int wgid = (int)L; { const int q = nwg / NXCD, r = nwg % NXCD, xcd = wgid % NXCD, off = wgid / NXCD; wgid = (xcd < r ? xcd * (q + 1) : r * (q + 1) + (xcd - r) * q) + off; }
        const int nig = wgm * nN, gid = wgid / nig, fm = gid * wgm, gsz = (nM - fm) < wgm ? (nM - fm) : wgm;
        u.pm = fm + ((wgid % nig) % gsz); u.pn = (wgid % nig) / gsz; return true;
    }
    __device__ __forceinline__ void a_ready(const Unit&) const {}
    __device__ __forceinline__ void done(const Unit&) const {}
};

__device__ __forceinline__ unsigned cvt_pk_bf16(float lo, float hi) { unsigned r; asm volatile("v_cvt_pk_bf16_f32 %0, %1, %2" : "=v"(r) : "v"(lo), "v"(hi)); return r; }

typedef PG8_LAS float lfloat;
#ifndef RESID_F16
#define RESID_F16 0
#endif
typedef _Float16 f16x8_t __attribute__((ext_vector_type(8))); typedef _Float16 f16x2_t __attribute__((ext_vector_type(2))); typedef float f32x2p_t __attribute__((ext_vector_type(2)));
template <bool F16> __device__ __forceinline__ f32x4 mma16(bf16x8 b, bf16x8 a, f32x4 c) {
    if constexpr (F16) return __builtin_amdgcn_mfma_f32_16x16x32_f16(__builtin_bit_cast(f16x8_t, b), __builtin_bit_cast(f16x8_t, a), c, 0, 0, 0);
    else return __builtin_amdgcn_mfma_f32_16x16x32_bf16(b, a, c, 0, 0, 0);
}
__device__ __forceinline__ unsigned pk2h(float lo, float hi) { const f32x2p_t v = {lo, hi}; const f16x2_t hv = __builtin_convertvector(v, f16x2_t); return __builtin_bit_cast(unsigned, hv); }
__device__ __forceinline__ f32x2p_t unpk2h(unsigned w) { return __builtin_convertvector(__builtin_bit_cast(f16x2_t, w), f32x2p_t); }
__device__ __forceinline__ int opaque_tid() { int t = threadIdx.x; asm volatile("" : "+v"(t)); return t; }
__device__ __forceinline__ float dpp_ror1(float v) { return __builtin_bit_cast(float, __builtin_amdgcn_update_dpp(0, __builtin_bit_cast(int, v), 0x121, 0xf, 0xf, false)); }
__device__ __forceinline__ float dpp_ror2(float v) { return __builtin_bit_cast(float, __builtin_amdgcn_update_dpp(0, __builtin_bit_cast(int, v), 0x122, 0xf, 0xf, false)); }
__device__ __forceinline__ float dpp_ror4(float v) { return __builtin_bit_cast(float, __builtin_amdgcn_update_dpp(0, __builtin_bit_cast(int, v), 0x124, 0xf, 0xf, false)); }
__device__ __forceinline__ float dpp_ror8(float v) { return __builtin_bit_cast(float, __builtin_amdgcn_update_dpp(0, __builtin_bit_cast(int, v), 0x128, 0xf, 0xf, false)); }
__device__ __forceinline__ float row16_sum(float v) {
    asm volatile("s_nop 1\n\tv_add_f32_dpp %0, %0, %0 row_ror:8 row_mask:0xf bank_mask:0xf\n\ts_nop 1\n\tv_add_f32_dpp %0, %0, %0 row_ror:4 row_mask:0xf bank_mask:0xf\n\t"
                 "s_nop 1\n\tv_add_f32_dpp %0, %0, %0 row_ror:2 row_mask:0xf bank_mask:0xf\n\ts_nop 1\n\tv_add_f32_dpp %0, %0, %0 row_ror:1 row_mask:0xf bank_mask:0xf" : "+v"(v));
    return v; }
__device__ __forceinline__ float fq_sum(float v) {
    auto a = __builtin_amdgcn_permlane32_swap(__float_as_uint(v), __float_as_uint(v), false, false); v = __uint_as_float(a[0]) + __uint_as_float(a[1]);
    auto b = __builtin_amdgcn_permlane16_swap(__float_as_uint(v), __float_as_uint(v), false, false); return __uint_as_float(b[0]) + __uint_as_float(b[1]); }
#define EPI_BAR() do { asm volatile("s_waitcnt lgkmcnt(0)" ::: "memory"); __builtin_amdgcn_s_barrier(); asm volatile("" ::: "memory"); } while (0)

template <int MODE> struct EpiProj {
    static constexpr bool PERM = true, AFTER_DRAIN = false, F16A = (RESID_F16 != 0) && (MODE != 3);
    bf16_t* O; int ldc; lfloat* rtab; lfloat* exch; const float* g0; const float* g1; float* km2;
    __device__ __forceinline__ void operator()(f32x4 (&acc)[2][2][4][2], const Unit& u, int ui, int wr, int wc, int fr_, int fq_) const {
        int fr = fr_, fq = fq_; asm volatile("" : "+v"(fr), "+v"(fq));
#pragma unroll
        for (int ai = 0; ai < 2; ++ai)
#pragma unroll
            for (int m = 0; m < 4; ++m) { const float r = rtab[ui * 256 + ai * HALF + wr * 64 + m * 16 + fr];
#pragma unroll
                for (int bj = 0; bj < 2; ++bj)
#pragma unroll
                    for (int n = 0; n < 2; ++n) acc[ai][bj][m][n] = acc[ai][bj][m][n] * r; }
        const float* gpa = nullptr; const float* gpb = nullptr; constexpr int HW = 64;
        if (MODE == 0) { const int seg = u.pn >> 1; if (seg == 3) { gpa = g0; gpb = g0; } else if (seg == 4) { gpa = g1; gpb = g1; } }
        if (MODE == 1) { if (u.pn < 4) { gpa = g0; gpb = g0; } else { gpa = g1; } }
        if (gpa != nullptr || gpb != nullptr) {
#pragma unroll
            for (int ai = 0; ai < 2; ++ai)
#pragma unroll
                for (int m = 0; m < 4; ++m)
#pragma unroll
                    for (int bj = 0; bj < 2; ++bj) { float s = 0.f;
#pragma unroll
                        for (int n = 0; n < 2; ++n) { const f32x4 x = acc[ai][bj][m][n]; s += (x[0] * x[0] + x[1] * x[1]) + (x[2] * x[2] + x[3] * x[3]); }
                        s = fq_sum(s);
                        if (fq == 0) exch[(bj * 256 + ai * HALF + wr * 64 + m * 16 + fr) * 4 + wc] = s; }
            EPI_BAR();
#pragma unroll
            for (int bj = 0; bj < 2; ++bj) { const float* gp = bj == 0 ? gpa : gpb;
                if (gp != nullptr) {
                    const int ch = (HW == 64 ? 32 * (wc & 1) : 32 * wc) + 8 * fq;
                    const f32x4 ga = *(const f32x4*)(gp + ch), gb = *(const f32x4*)(gp + ch + 4);
#pragma unroll
                    for (int ai = 0; ai < 2; ++ai)
#pragma unroll
                        for (int m = 0; m < 4; ++m) { const int e = (bj * 256 + ai * HALF + wr * 64 + m * 16 + fr) * 4; float tot;
                            if (HW == 64) tot = exch[e + wc] + exch[e + (wc ^ 1)]; else { const f32x4 t4 = *(const PG8_LAS f32x4*)(exch + e); tot = (t4[0] + t4[1]) + (t4[2] + t4[3]); }
                            const float rn = __builtin_amdgcn_rsqf(tot * (1.0f / HW) + 1e-6f);
                            acc[ai][bj][m][0] = acc[ai][bj][m][0] * rn * ga; acc[ai][bj][m][1] = acc[ai][bj][m][1] * rn * gb; asm volatile("" ::: "memory"); }
                }
            }
        }
        if (MODE == 0) { if ((u.pn >> 1) == 4) {
#pragma unroll
            for (int bj = 0; bj < 2; ++bj)
#pragma unroll
                for (int n = 0; n < 2; ++n) { f32x4 cs = (f32x4){0.f, 0.f, 0.f, 0.f};
#pragma unroll
                    for (int ai = 0; ai < 2; ++ai)
#pragma unroll
                        for (int m = 0; m < 4; ++m) cs = cs + acc[ai][bj][m][n];
                    cs[0] = row16_sum(cs[0]); cs[1] = row16_sum(cs[1]); cs[2] = row16_sum(cs[2]); cs[3] = row16_sum(cs[3]);
                    if (fr == 0) *(f32x4*)(km2 + (size_t)(u.pm * 2 + wr) * 512 + (u.pn - 8) * 256 + bj * HALF + wc * 32 + 8 * fq + 4 * n) = cs; }
        } }
        const int row0 = u.pm * BM + wr * 64 + fr, col0 = u.pn * BM + wc * 32 + 8 * fq;
#pragma unroll
        for (int ai = 0; ai < 2; ++ai)
#pragma unroll
            for (int m = 0; m < 4; ++m) {
#pragma unroll
                for (int bj = 0; bj < 2; ++bj) { const f32x4 v0 = acc[ai][bj][m][0], v1 = acc[ai][bj][m][1]; u32x4 w;
                    w.x = cvt_pk_bf16(v0[0], v0[1]); w.y = cvt_pk_bf16(v0[2], v0[3]); w.z = cvt_pk_bf16(v1[0], v1[1]); w.w = cvt_pk_bf16(v1[2], v1[3]);
                    const int row = row0 + ai * HALF + m * 16;
                    if (MODE == 0) {
                        const int hd = (u.pn & 1) * 4 + bj * 2 + (wc >> 1), d = (wc & 1) * 32 + 8 * fq;
                        *(u32x4*)(O + (size_t)(u.pn >> 1) * ((size_t)32768 * 512) + ((size_t)((row >> 13) * 8 + hd) * 8192 + (row & 8191)) * 64 + d) = w;
                    } else *(u32x4*)(O + (size_t)row * ldc + col0 + bj * HALF) = w; } }
    }
};

template <bool IN32, bool OUT32> struct EpiRes {
    static constexpr bool PERM = true, AFTER_DRAIN = false, F16A = false;
    const float* Xin32; float* Xout32; bf16_t* XB; float* SS;
    __device__ __forceinline__ void operator()(f32x4 (&acc)[2][2][4][2], const Unit& u, int ui, int wr, int wc, int fr_, int fq_) const {
        int fr = fr_, fq = fq_; asm volatile("" : "+v"(fr), "+v"(fq));
        const int row0 = u.pm * BM + wr * 64 + fr, col0 = u.pn * BM + wc * 32 + 8 * fq;
#pragma unroll
        for (int ai = 0; ai < 2; ++ai)
#pragma unroll
            for (int m = 0; m < 4; ++m) { const size_t off = (size_t)(row0 + ai * HALF + m * 16) * 1024 + col0; float s = 0.f;
#pragma unroll
                for (int bj = 0; bj < 2; ++bj) { f32x4 v0, v1;
                    if (IN32) { const float* xi = Xin32 + off + bj * HALF; v0 = *(const f32x4*)xi; v1 = *(const f32x4*)(xi + 4); }
                    else { const u32x4 w = *(const u32x4*)(XB + off + bj * HALF);
                        if (RESID_F16) { const f32x2p_t a = unpk2h(w.x), b = unpk2h(w.y), c2 = unpk2h(w.z), d = unpk2h(w.w); v0 = (f32x4){a.x, a.y, b.x, b.y}; v1 = (f32x4){c2.x, c2.y, d.x, d.y}; }
                        else { v0 = (f32x4){__builtin_bit_cast(float, w.x << 16), __builtin_bit_cast(float, w.x & 0xffff0000u), __builtin_bit_cast(float, w.y << 16), __builtin_bit_cast(float, w.y & 0xffff0000u)};
                               v1 = (f32x4){__builtin_bit_cast(float, w.z << 16), __builtin_bit_cast(float, w.z & 0xffff0000u), __builtin_bit_cast(float, w.w << 16), __builtin_bit_cast(float, w.w & 0xffff0000u)}; } }
                    v0 = v0 + acc[ai][bj][m][0]; v1 = v1 + acc[ai][bj][m][1];
                    if (OUT32) { float* xp = Xout32 + off + bj * HALF; __builtin_nontemporal_store(v0, (f32x4*)xp); __builtin_nontemporal_store(v1, (f32x4*)(xp + 4)); }
                    s += (v0[0] * v0[0] + v0[1] * v0[1]) + (v0[2] * v0[2] + v0[3] * v0[3]) + (v1[0] * v1[0] + v1[1] * v1[1]) + (v1[2] * v1[2] + v1[3] * v1[3]);
                    u32x4 w; if (RESID_F16) { w.x = pk2h(v0[0], v0[1]); w.y = pk2h(v0[2], v0[3]); w.z = pk2h(v1[0], v1[1]); w.w = pk2h(v1[2], v1[3]); } else { w.x = cvt_pk_bf16(v0[0], v0[1]); w.y = cvt_pk_bf16(v0[2], v0[3]); w.z = cvt_pk_bf16(v1[0], v1[1]); w.w = cvt_pk_bf16(v1[2], v1[3]); }
                    *(u32x4*)(XB + off + bj * HALF) = w; }
                s = fq_sum(s);
                if (fq == 0) SS[(size_t)(row0 + ai * HALF + m * 16) * 16 + u.pn * 4 + wc] = s;
                asm volatile("" ::: "memory"); }
    }
};

struct EpiFfnUp {
    static constexpr bool PERM = true, AFTER_DRAIN = false, F16A = (RESID_F16 != 0);
    bf16_t* G; lfloat* rtab; lfloat* exch; const float* cw; const float* cb; float* halo;
    __device__ __forceinline__ void operator()(f32x4 (&acc)[2][2][4][2], const Unit& u, int ui, int wr, int wc, int fr_, int fq_) const {
        int fr = fr_, fq = fq_; asm volatile("" : "+v"(fr), "+v"(fq));
#pragma unroll
        for (int ai = 0; ai < 2; ++ai)
#pragma unroll
            for (int m = 0; m < 4; ++m) { const float r = rtab[ui * 256 + ai * HALF + wr * 64 + m * 16 + fr];
#pragma unroll
                for (int bj = 0; bj < 2; ++bj)
#pragma unroll
                    for (int n = 0; n < 2; ++n) acc[ai][bj][m][n] = acc[ai][bj][m][n] * r; }
        const int fbase = u.pn * 128 + 32 * wc + 8 * fq;
        if (wr == 0 && fr < 2) {
#pragma unroll
            for (int bj = 0; bj < 2; ++bj)
#pragma unroll
                for (int n = 0; n < 2; ++n) *(f32x4*)(halo + (size_t)(u.pm * 4 + fr) * 5632 + bj * 2816 + fbase + 4 * n) = acc[0][bj][0][n];
        }
        if (wr == 1 && fr >= 14) {
#pragma unroll
            for (int bj = 0; bj < 2; ++bj)
#pragma unroll
                for (int n = 0; n < 2; ++n) *(f32x4*)(halo + (size_t)(u.pm * 4 + 2 + (fr - 14)) * 5632 + bj * 2816 + fbase + 4 * n) = acc[1][bj][3][n];
        }
        if (fr >= 14) {
#pragma unroll
            for (int ai = 0; ai < 2; ++ai)
#pragma unroll
                for (int bj = 0; bj < 2; ++bj)
#pragma unroll
                    for (int n = 0; n < 2; ++n) *(PG8_LAS f32x4*)(exch + (((2 * ai + wr) * 2 + (fr - 14)) * 256 + bj * HALF + 32 * wc + 8 * fq + 4 * n)) = acc[ai][bj][3][n];
        }
        EPI_BAR();
#pragma unroll
        for (int bj = 0; bj < 2; ++bj)
#pragma unroll
            for (int n = 0; n < 2; ++n) { const int ch = bj * 2816 + fbase + 4 * n;
                const f32x4 w0 = *(const f32x4*)(cw + ch), w1 = *(const f32x4*)(cw + 5632 + ch), w2 = *(const f32x4*)(cw + 2 * 5632 + ch), bb = *(const f32x4*)(cb + ch);
#pragma unroll
                for (int ai = 0; ai < 2; ++ai) { const int kb = 2 * ai + wr;
                    f32x4 c62 = (f32x4){0.f, 0.f, 0.f, 0.f}, c63 = c62;
                    if (kb > 0) { c62 = *(const PG8_LAS f32x4*)(exch + (((kb - 1) * 2 + 0) * 256 + bj * HALF + 32 * wc + 8 * fq + 4 * n)); c63 = *(const PG8_LAS f32x4*)(exch + (((kb - 1) * 2 + 1) * 256 + bj * HALF + 32 * wc + 8 * fq + 4 * n)); }
#pragma unroll
                    for (int m = 3; m >= 0; --m) { f32x4 cur = acc[ai][bj][m][n], res;
#pragma unroll
                        for (int j = 0; j < 4; ++j) { const float c = cur[j]; const float pv = (m > 0) ? acc[ai][bj][m > 0 ? m - 1 : 0][n][j] : (fr == 15 ? c63[j] : c62[j]); float t1, t2;
                            asm volatile("s_nop 1\n\tv_mov_b32_dpp %0, %3 row_ror:1 row_mask:0xf bank_mask:0xf\n\tv_mov_b32_dpp %1, %3 row_ror:2 row_mask:0xf bank_mask:0xf\n\t"
                                         "v_mov_b32_dpp %0, %2 row_shr:1 row_mask:0xf bank_mask:0xf\n\tv_mov_b32_dpp %1, %2 row_shr:2 row_mask:0xf bank_mask:0xf"
                                         : "=&v"(t1), "=&v"(t2) : "v"(c), "v"(pv));
                            res[j] = bb[j] + w0[j] * t2 + w1[j] * t1 + w2[j] * c; }
                        asm volatile("" : "+v"(res[0]), "+v"(res[1]), "+v"(res[2]), "+v"(res[3]));
                        acc[ai][bj][m][n] = res; } }
                asm volatile("" ::: "memory"); }
        const int row0 = u.pm * BM + wr * 64 + fr;
#pragma unroll
        for (int ai = 0; ai < 2; ++ai)
#pragma unroll
            for (int m = 0; m < 4; ++m) { float gv[8];
#pragma unroll
                for (int n = 0; n < 2; ++n)
#pragma unroll
                    for (int j = 0; j < 4; ++j) { const float g = acc[ai][0][m][n][j], up = acc[ai][1][m][n][j]; gv[n * 4 + j] = g * __builtin_amdgcn_rcpf(1.0f + __builtin_amdgcn_exp2f(g * -1.4426950408889634f)) * up; }
                u32x4 w; w.x = cvt_pk_bf16(gv[0], gv[1]); w.y = cvt_pk_bf16(gv[2], gv[3]); w.z = cvt_pk_bf16(gv[4], gv[5]); w.w = cvt_pk_bf16(gv[6], gv[7]);
                *(u32x4*)(G + (size_t)(row0 + ai * HALF + m * 16) * 2816 + fbase) = w; asm volatile("" ::: "memory"); }
    }
};
template <class Epi, class Sched, bool ALIGN_EPI = false, bool SP2 = false>
__device__ __forceinline__ void gemm_phase(PG8_LAS unsigned char* lds, const Gemm g, const Sched& S, const Epi& E) {
    const int tid = opaque_tid(), wid = __builtin_amdgcn_readfirstlane(tid >> 6), lane = tid & 63, wr = wid >> 2, wc = wid & 3, fr = lane & 15, fq = lane >> 4;
    const int K = g.K, nt = K / BK;
    unsigned voffA[2], voffB[2];
#pragma unroll
    for (int i = 0; i < 2; ++i) { int R, C; stage_rc(tid * 16 + i * 8192, R, C); const int Rb = Epi::PERM ? ((R & ~31) + perm32(R & 31)) : R;
        voffA[i] = (unsigned)(R * K + C) * 2u; voffB[i] = (unsigned)(Rb * K + C) * 2u; }
    const size_t kstep = (size_t)(BK * 2);
    const size_t hstep = (size_t)HALF * K * 2;
    const size_t tstep = 2 * hstep;
    const unsigned ldsw = (unsigned)wid * 1024u;
    const int aoff = lds_byte(wr * 64 + fr, fq * 8), boff = lds_byte(wc * 32 + fr, fq * 8);
#define PG8_SA(b, h) (((b) * 2 + (h)) * HTB)
#define PG8_SB(b, h) ((4 + (b) * 2 + (h)) * HTB)
#define PG8_STAGE(bufoff, gbase, voff) do { _Pragma("unroll") for (int _i = 0; _i < 2; ++_i) \
        __builtin_amdgcn_global_load_lds((const unsigned*)((const char*)(gbase) + (voff)[_i]), (PG8_LAS unsigned*)(lds + (bufoff) + ldsw + _i * 8192), 16, 0, 0); } while (0)
#define PG8_LDA(dst, b, h) do { _Pragma("unroll") for (int m = 0; m < 4; ++m) _Pragma("unroll") for (int k = 0; k < 2; ++k) dst[m][k] = *(const PG8_LAS bf16x8*)(lds + PG8_SA(b, h) + aoff + m * 2048 + k * 1024); } while (0)
#define PG8_LDB(dst, b, h) do { _Pragma("unroll") for (int n = 0; n < 2; ++n) _Pragma("unroll") for (int k = 0; k < 2; ++k) dst[n][k] = *(const PG8_LAS bf16x8*)(lds + PG8_SB(b, h) + boff + n * 2048 + k * 1024); } while (0)
#define PG8_MMA(ai, bj, At, Bt) do { __builtin_amdgcn_s_setprio(1); _Pragma("unroll") for (int m = 0; m < 4; ++m) _Pragma("unroll") for (int n = 0; n < 2; ++n) _Pragma("unroll") for (int k = 0; k < 2; ++k) \
        acc[ai][bj][m][n] = mma16<Epi::F16A>(Bt[n][k], At[m][k], acc[ai][bj][m][n]); __builtin_amdgcn_s_setprio(0); } while (0)
#define PG8_WAIT_V(n) asm volatile("s_waitcnt vmcnt(" #n ")" ::: "memory")
#define PG8_WAIT_L(n) asm volatile("s_waitcnt lgkmcnt(" #n ")" ::: "memory")
#define PG8_BAR __builtin_amdgcn_s_barrier()
#define PG8_SCHED __builtin_amdgcn_sched_barrier(0)
    Unit cur, nxt; int ui = 0;
    if (!S.next(0, cur)) return;
    f32x4 acc[2][2][4][2];
#pragma unroll
    for (int a = 0; a < 2; ++a)
#pragma unroll
        for (int b = 0; b < 2; ++b)
#pragma unroll
            for (int m = 0; m < 4; ++m)
#pragma unroll
                for (int n = 0; n < 2; ++n) acc[a][b][m][n] = (f32x4){0.f, 0.f, 0.f, 0.f};
    bf16x8 At[4][2], B0[2][2], B1[2][2];
    const char* cA = (const char*)g.A + (size_t)cur.pm * tstep; const char* cB = (const char*)g.Bt + (size_t)cur.pn * tstep;
    S.a_ready(cur);
    if constexpr (SP2) {
        PG8_STAGE(PG8_SB(0, 0), cB, voffB); PG8_STAGE(PG8_SB(0, 1), cB + hstep, voffB); PG8_STAGE(PG8_SA(0, 0), cA, voffA); PG8_STAGE(PG8_SA(0, 1), cA + hstep, voffA);
        if (wr == 1) PG8_BAR;
        PG8_WAIT_V(2); PG8_BAR;
        PG8_STAGE(PG8_SB(1, 0), cB + kstep, voffB); PG8_STAGE(PG8_SA(1, 0), cA + kstep, voffA); PG8_STAGE(PG8_SB(1, 1), cB + hstep + kstep, voffB);
        PG8_WAIT_V(6); PG8_BAR;
    } else {
        PG8_STAGE(PG8_SB(0, 0), cB, voffB); PG8_STAGE(PG8_SA(0, 0), cA, voffA); PG8_STAGE(PG8_SB(0, 1), cB + hstep, voffB); PG8_STAGE(PG8_SA(0, 1), cA + hstep, voffA);
        if (wr == 1) PG8_BAR;
        PG8_WAIT_V(4); PG8_BAR;
        PG8_STAGE(PG8_SB(1, 0), cB + kstep, voffB); PG8_STAGE(PG8_SA(1, 0), cA + kstep, voffA); PG8_STAGE(PG8_SB(1, 1), cB + hstep + kstep, voffB);
        PG8_WAIT_V(6); PG8_BAR;
    }
    for (;;) {
        const bool has_next = S.next(ui + 1, nxt);
        const char* nA = has_next ? (const char*)g.A + (size_t)nxt.pm * tstep : cA; const char* nB = has_next ? (const char*)g.Bt + (size_t)nxt.pn * tstep : cB;
        for (int t = 0; t < nt; t += 2) {
            const bool last = (t == nt - 2);
            const char* a1 = cA + (size_t)(t + 1) * kstep;
            const char* a2 = last ? nA : cA + (size_t)(t + 2) * kstep; const char* b2 = last ? nB : cB + (size_t)(t + 2) * kstep;
            const char* a3 = a2 + kstep; const char* b3 = b2 + kstep;
            if (last && has_next) S.a_ready(nxt);
            if constexpr (SP2) {
            PG8_LDB(B0, 0, 0); PG8_LDB(B1, 0, 1); PG8_SCHED; PG8_LDA(At, 0, 0); PG8_STAGE(PG8_SA(1, 1), a1 + hstep, voffA);
            PG8_WAIT_V(8); PG8_WAIT_L(0); PG8_BAR; PG8_MMA(0, 0, At, B0); PG8_MMA(0, 1, At, B1); PG8_BAR; PG8_SCHED;
            PG8_LDA(At, 0, 1); PG8_STAGE(PG8_SB(0, 0), b2, voffB); PG8_STAGE(PG8_SB(0, 1), b2 + hstep, voffB); PG8_STAGE(PG8_SA(0, 0), a2, voffA);
            PG8_WAIT_V(8); PG8_WAIT_L(0); PG8_BAR; PG8_MMA(1, 0, At, B0); PG8_MMA(1, 1, At, B1); PG8_BAR; PG8_SCHED;
            PG8_LDB(B0, 1, 0); PG8_LDB(B1, 1, 1); PG8_SCHED; PG8_LDA(At, 1, 0); PG8_STAGE(PG8_SA(0, 1), a2 + hstep, voffA);
            PG8_WAIT_V(8); PG8_WAIT_L(0); PG8_BAR; PG8_MMA(0, 0, At, B0); PG8_MMA(0, 1, At, B1); PG8_BAR; PG8_SCHED;
            PG8_LDA(At, 1, 1); PG8_STAGE(PG8_SB(1, 0), b3, voffB); PG8_STAGE(PG8_SB(1, 1), b3 + hstep, voffB); PG8_STAGE(PG8_SA(1, 0), a3, voffA);
            PG8_WAIT_V(8); PG8_WAIT_L(0); PG8_BAR; PG8_MMA(1, 0, At, B0); PG8_MMA(1, 1, At, B1); PG8_BAR; PG8_SCHED;
            } else {
            PG8_LDB(B0, 0, 0); PG8_SCHED; PG8_LDA(At, 0, 0); PG8_STAGE(PG8_SA(1, 1), a1 + hstep, voffA);
            PG8_WAIT_L(8); PG8_BAR; PG8_WAIT_L(0); PG8_MMA(0, 0, At, B0); PG8_BAR; PG8_SCHED;
            PG8_LDB(B1, 0, 1); PG8_STAGE(PG8_SB(0, 0), b2, voffB);
            PG8_BAR; PG8_WAIT_L(0); PG8_MMA(0, 1, At, B1); PG8_BAR;
            PG8_LDA(At, 0, 1); PG8_STAGE(PG8_SA(0, 0), a2, voffA);
            PG8_BAR; PG8_WAIT_L(0); PG8_MMA(1, 0, At, B0); PG8_BAR; PG8_SCHED;
            PG8_STAGE(PG8_SB(0, 1), b2 + hstep, voffB);
            PG8_WAIT_V(6); PG8_BAR; PG8_MMA(1, 1, At, B1); PG8_BAR;
            PG8_LDB(B0, 1, 0); PG8_SCHED; PG8_LDA(At, 1, 0); PG8_STAGE(PG8_SA(0, 1), a2 + hstep, voffA);
            PG8_WAIT_L(8); PG8_BAR; PG8_WAIT_L(0); PG8_MMA(0, 0, At, B0); PG8_BAR; PG8_SCHED;
            PG8_LDB(B1, 1, 1); PG8_STAGE(PG8_SB(1, 0), b3, voffB);
            PG8_BAR; PG8_WAIT_L(0); PG8_MMA(0, 1, At, B1); PG8_BAR;
            PG8_LDA(At, 1, 1); PG8_STAGE(PG8_SA(1, 0), a3, voffA);
            PG8_BAR; PG8_WAIT_L(0); PG8_MMA(1, 0, At, B0); PG8_BAR; PG8_SCHED;
            PG8_STAGE(PG8_SB(1, 1), b3 + hstep, voffB);
            PG8_WAIT_V(6); PG8_BAR; PG8_MMA(1, 1, At, B1); PG8_BAR;
            }
        }
        if constexpr (ALIGN_EPI) { if (wr == 0) PG8_BAR; }
        if constexpr (!Epi::AFTER_DRAIN) { E(acc, cur, ui, wr, wc, fr, fq); S.done(cur); }
        if (!has_next) break;
#pragma unroll
        for (int a = 0; a < 2; ++a)
#pragma unroll
            for (int b = 0; b < 2; ++b)
#pragma unroll
                for (int m = 0; m < 4; ++m)
#pragma unroll
                    for (int n = 0; n < 2; ++n) acc[a][b][m][n] = (f32x4){0.f, 0.f, 0.f, 0.f};
        cur = nxt; cA = nA; cB = nB; ++ui;
        if constexpr (ALIGN_EPI) { if (wr == 1) PG8_BAR; }
    }
    PG8_WAIT_V(0);
    if constexpr (!ALIGN_EPI) { if (wr == 0) PG8_BAR; }
    PG8_BAR;
    static_assert(!Epi::AFTER_DRAIN, "no drained epilogues here");
#undef PG8_SA
#undef PG8_SB
#undef PG8_STAGE
#undef PG8_LDA
#undef PG8_LDB
#undef PG8_MMA
#undef PG8_WAIT_V
#undef PG8_WAIT_L
#undef PG8_BAR
#undef PG8_SCHED
}
}

#define LAS __attribute__((address_space(3)))
typedef unsigned short bf16;
typedef short s16x8 __attribute__((ext_vector_type(8)));
typedef short s16x4 __attribute__((ext_vector_type(4)));
typedef float f32x4 __attribute__((ext_vector_type(4)));
typedef float f32x16 __attribute__((ext_vector_type(16)));
typedef unsigned u32x4 __attribute__((ext_vector_type(4)));
typedef unsigned u32x2 __attribute__((ext_vector_type(2)));
typedef LAS unsigned char lbyte;

#ifndef WGM_UP
#define WGM_UP 4
#endif
#ifndef WGM_IN
#define WGM_IN 4
#endif
constexpr int NT = 512;
constexpr int D = 1024, BATCH = 4, SEQ = 8192, M = BATCH * SEQ, DFF = 2816, MEMLEN = 256, MROWS = BATCH * MEMLEN;
constexpr size_t MiB = 1u << 20;
constexpr size_t W_EV_IN = 0, W_EV_OUT = W_EV_IN + 2ull * 3072 * 1024, W_OD_IN = W_EV_OUT + 2ull * 1024 * 1024, W_OD_OUT = W_OD_IN + 2ull * 1280 * 1024,
                 W_CQ = W_OD_OUT + 2ull * 1024 * 1024, W_CKV = W_CQ + 4ull * 512 * 1024, W_CO = W_CKV + 4096ull * 1024, W_UP = W_CO + 4ull * 1024 * 512,
                 W_DN = W_UP + 4ull * 5632 * 1024, W_END = W_DN + 4ull * 1024 * 2816;
static_assert(W_END * 2 <= 108 * MiB, "weights fit");
constexpr size_t WS_W = 0, WS_XB = 108 * MiB, WS_QKV = 172 * MiB, WS_G = WS_QKV, WS_AO = 364 * MiB, WS_CQ = 428 * MiB, WS_CKV = 460 * MiB, WS_MEMB = 468 * MiB,
                 WS_SS = 470 * MiB, WS_SSM = 472 * MiB, WS_KM2 = 473 * MiB, WS_HALO = 474 * MiB, WS_CTL = 486 * MiB, CTL_BYTES = 65536, WS_END = 487 * MiB;
static_assert((size_t)M * 3072 * 2 <= WS_AO - WS_QKV && (size_t)M * DFF * 2 <= WS_AO - WS_QKV && (size_t)128 * 4 * 5632 * 4 <= WS_CTL - WS_HALO, "ws map");
constexpr int LDS_RING = 0, LDS_RTAB = 131072, LDS_EXCH = LDS_RTAB + 12288, LDS_BYTES = LDS_EXCH + 8192 + 1024;
constexpr int KP64 = 144;

struct Args { const float* in[25]; float* out; unsigned char* ws; int ph_lo, ph_hi; };

typedef float f32x2_t __attribute__((ext_vector_type(2))); typedef __bf16 bf16x2_t __attribute__((ext_vector_type(2)));
__device__ __forceinline__ unsigned pk2(float lo, float hi) { f32x2_t v = {lo, hi}; bf16x2_t b = __builtin_convertvector(v, bf16x2_t); return __builtin_bit_cast(unsigned, b); }
__device__ __forceinline__ float bf2f(unsigned short b) { return __builtin_bit_cast(float, (unsigned)b << 16); }
__device__ __forceinline__ float wave_sum(float v) {
#pragma unroll
    for (int o = 1; o < 64; o <<= 1) v += __shfl_xor(v, o);
    return v;
}
__device__ __forceinline__ float pair_max(float v) { auto r = __builtin_amdgcn_permlane32_swap(__float_as_uint(v), __float_as_uint(v), false, false); return fmaxf(__uint_as_float(r[0]), __uint_as_float(r[1])); }
__device__ __forceinline__ float pair_sum(float v) { auto r = __builtin_amdgcn_permlane32_swap(__float_as_uint(v), __float_as_uint(v), false, false); return __uint_as_float(r[0]) + __uint_as_float(r[1]); }
__device__ __forceinline__ float pair_other(float v, int h) { auto r = __builtin_amdgcn_permlane32_swap(__float_as_uint(v), __float_as_uint(v), false, false); return h ? __uint_as_float(r[0]) : __uint_as_float(r[1]); }

#define MFMA32(a, b, c) __builtin_amdgcn_mfma_f32_32x32x16_bf16(a, b, c, 0, 0, 0)
__device__ __forceinline__ int kkrow(int r, int h) { return 8 * (r >> 2) + 4 * h + (r & 3); }
__device__ __forceinline__ int t5_bucket(int d) {
    const int dc = d < 16 ? 16 : d;
    const int e = 31 - __clz(dc); const unsigned dd = (unsigned)dc * (unsigned)dc; const int half = dd >= (2u << (2 * e)) ? 1 : 0; int b = 2 * e + half + 8; b = b < 31 ? b : 31;
    return d < 16 ? d : b;
}
constexpr float LOG2E = 1.4426950408889634f;
template <int DCH> __device__ __forceinline__ f32x16 qk_sub(const lbyte* krows, int pitchB, const s16x8* qf, int l31, int h) {
    f32x16 s;
#pragma unroll
    for (int r = 0; r < 16; ++r) s[r] = 0.f;
    const lbyte* p = krows + l31 * pitchB + h * 16;
#pragma unroll
    for (int c = 0; c < DCH; ++c) { const s16x8 a = *(const LAS s16x8*)(p + c * 32); s = MFMA32(a, qf[c], s); }
    return s;
}
template <int DT> __device__ __forceinline__ void pv_sub(f32x16* o, const lbyte* vkeys, int vpitchB, s16x8 p0, s16x8 p1, int l31, int h) {
#pragma unroll
    for (int dt = 0; dt < DT; ++dt) { const lbyte* p = vkeys + (32 * dt + l31) * vpitchB + h * 8;
        const u32x2 a0 = *(const LAS u32x2*)(p), a1 = *(const LAS u32x2*)(p + 16), a2 = *(const LAS u32x2*)(p + 32), a3 = *(const LAS u32x2*)(p + 48);
        const s16x8 A0 = __builtin_bit_cast(s16x8, (u32x4){a0.x, a0.y, a1.x, a1.y}), A1 = __builtin_bit_cast(s16x8, (u32x4){a2.x, a2.y, a3.x, a3.y});
        o[dt] = MFMA32(A0, p0, o[dt]); o[dt] = MFMA32(A1, p1, o[dt]); }
}
__device__ __forceinline__ void pack_p(const f32x16& s, s16x8& p0, s16x8& p1) {
    u32x4 a, b; a.x = pk2(s[0], s[1]); a.y = pk2(s[2], s[3]); a.z = pk2(s[4], s[5]); a.w = pk2(s[6], s[7]); b.x = pk2(s[8], s[9]); b.y = pk2(s[10], s[11]); b.z = pk2(s[12], s[13]); b.w = pk2(s[14], s[15]);
    p0 = __builtin_bit_cast(s16x8, a); p1 = __builtin_bit_cast(s16x8, b);
}
template <int DCH> __device__ __forceinline__ void load_k(s16x8* kf, const lbyte* krows, int pitchB, int l31, int h) {
    const lbyte* p = krows + l31 * pitchB + h * 16;
#pragma unroll
    for (int c = 0; c < DCH; ++c) kf[c] = *(const LAS s16x8*)(p + c * 32);
}
template <int DT> __device__ __forceinline__ void load_v(s16x8* vf  , const lbyte* vkeys, int vpitchB, int l31, int h) {
#pragma unroll
    for (int dt = 0; dt < DT; ++dt) { const lbyte* p = vkeys + (32 * dt + l31) * vpitchB + h * 8;
        const u32x2 a0 = *(const LAS u32x2*)(p), a1 = *(const LAS u32x2*)(p + 16), a2 = *(const LAS u32x2*)(p + 32), a3 = *(const LAS u32x2*)(p + 48);
        vf[dt * 2 + 0] = __builtin_bit_cast(s16x8, (u32x4){a0.x, a0.y, a1.x, a1.y}); vf[dt * 2 + 1] = __builtin_bit_cast(s16x8, (u32x4){a2.x, a2.y, a3.x, a3.y}); }
}
template <int DCH> __device__ __forceinline__ void qk2(f32x16& s0, f32x16& s1, const s16x8* k0, const s16x8* k1, const s16x8* qf) {
#pragma unroll
    for (int r = 0; r < 16; ++r) { s0[r] = 0.f; s1[r] = 0.f; }
#pragma unroll
    for (int c = 0; c < DCH; ++c) { s0 = MFMA32(k0[c], qf[c], s0); s1 = MFMA32(k1[c], qf[c], s1); }
}
template <int DCH> __device__ __forceinline__ void qk1(f32x16& s0, const s16x8* k0, const s16x8* qf) {
#pragma unroll
    for (int r = 0; r < 16; ++r) s0[r] = 0.f;
#pragma unroll
    for (int c = 0; c < DCH; ++c) s0 = MFMA32(k0[c], qf[c], s0);
}
template <int DT> __device__ __forceinline__ void pv1(f32x16* o, const s16x8* vf, s16x8 p0, s16x8 p1) {
#pragma unroll
    for (int dt = 0; dt < DT; ++dt) o[dt] = MFMA32(vf[dt * 2], p0, o[dt]);
#pragma unroll
    for (int dt = 0; dt < DT; ++dt) o[dt] = MFMA32(vf[dt * 2 + 1], p1, o[dt]);
}
#define LDS_FENCE() asm volatile("" ::: "memory")
template <int NS, int DT> __device__ __forceinline__ void softmax_upd(f32x16* s, float& m, float& l, f32x16* o) {
    float mx = s[0][0];
#pragma unroll
    for (int i = 0; i < NS; ++i)
#pragma unroll
        for (int r = 0; r < 16; ++r) mx = fmaxf(mx, s[i][r]);
    mx = pair_max(mx);
    const bool grow = mx > m + 8.0f; const float mn = grow ? mx : m; float sum = 0.f;
    if (__any(grow)) { const float alpha = __builtin_amdgcn_exp2f(m - mn); l *= alpha;
#pragma unroll
        for (int dt = 0; dt < DT; ++dt) o[dt] = o[dt] * alpha; }
    m = mn;
#pragma unroll
    for (int i = 0; i < NS; ++i)
#pragma unroll
        for (int r = 0; r < 16; ++r) { const float e = __builtin_amdgcn_exp2f(s[i][r] - mn); s[i][r] = e; sum += e; }
    sum = pair_sum(sum);
    l += sum;
}
template <int DT> __device__ __forceinline__ void store_o(const f32x16* o, float inv, bf16* outrow, int h) {
#pragma unroll
    for (int dt = 0; dt < DT; ++dt)
#pragma unroll
        for (int g = 0; g < 4; g += 2) {
            unsigned ax = pk2(o[dt][4 * g] * inv, o[dt][4 * g + 1] * inv), ay = pk2(o[dt][4 * g + 2] * inv, o[dt][4 * g + 3] * inv);
            unsigned bx = pk2(o[dt][4 * g + 4] * inv, o[dt][4 * g + 5] * inv), by = pk2(o[dt][4 * g + 6] * inv, o[dt][4 * g + 7] * inv);
            { auto r = __builtin_amdgcn_permlane32_swap(ax, bx, false, false); ax = r[0]; bx = r[1]; }
            { auto r = __builtin_amdgcn_permlane32_swap(ay, by, false, false); ay = r[0]; by = r[1]; }
            *(u32x4*)(outrow + 32 * dt + 8 * g + 8 * h) = (u32x4){ax, ay, bx, by}; }
}
struct Stage64 { u32x4 k, v; };
__device__ __forceinline__ void stage_load(Stage64& st, const bf16* kt, const bf16* vt, int tid) {
    st.k = *(const u32x4*)(kt + tid * 8); st.v = *(const u32x4*)(vt + (tid & 63) * 64 + (tid >> 6) * 8);
}
__device__ __forceinline__ void stage_write(const Stage64& st, lbyte* kbuf, lbyte* vbuf, int tid) {
    *(LAS u32x4*)(kbuf + (tid >> 3) * KP64 + (tid & 7) * 16) = st.k;
    LAS unsigned short* vp = (LAS unsigned short*)(vbuf + ((tid >> 6) * 8) * KP64 + (tid & 63) * 2);
    vp[0 * (KP64 / 2)] = (unsigned short)(st.v.x & 0xffffu); vp[1 * (KP64 / 2)] = (unsigned short)(st.v.x >> 16);
    vp[2 * (KP64 / 2)] = (unsigned short)(st.v.y & 0xffffu); vp[3 * (KP64 / 2)] = (unsigned short)(st.v.y >> 16);
    vp[4 * (KP64 / 2)] = (unsigned short)(st.v.z & 0xffffu); vp[5 * (KP64 / 2)] = (unsigned short)(st.v.z >> 16);
    vp[6 * (KP64 / 2)] = (unsigned short)(st.v.w & 0xffffu); vp[7 * (KP64 / 2)] = (unsigned short)(st.v.w >> 16);
}
constexpr size_t EVSEG = (size_t)M * 512;

constexpr int EV_KB = 0, EV_VB = 36864, EV_KMEAN = 73728, EV_SELM = 81920, EV_TAB = 82944, EV_FLAG = 83072, EV_THR = 83136, EV_DTAB = 83264;
__device__ __forceinline__ void moba_unit(lbyte* lds, const bf16* QKV, bf16* AO, const float* km2, const float* rel_bias, int b, int hm, int own) {
    const int tid = pg8::opaque_tid(), wid = __builtin_amdgcn_readfirstlane(tid >> 6), lane = tid & 63, l31 = lane & 31, h = lane >> 5;
    const int ocol = (8 + hm) * 64; const size_t rowbase = (size_t)b * SEQ, hbase = ((size_t)(b * 8 + hm) * SEQ) * 64;
    const bf16* Qh = QKV + 3 * EVSEG + hbase; const bf16* Kh = QKV + 4 * EVSEG + hbase; const bf16* Vh = QKV + 5 * EVSEG + hbase;
    LAS float* kmean = (LAS float*)(lds + EV_KMEAN); LAS unsigned* selm = (LAS unsigned*)(lds + EV_SELM); LAS float* tab = (LAS float*)(lds + EV_TAB);
    for (int idx = tid; idx < own * 64; idx += NT) { const int n = idx >> 6, d = idx & 63; const size_t blk = (size_t)b * 32 + n;
        kmean[idx] = (km2[(blk * 2 + 0) * 512 + 64 * hm + d] + km2[(blk * 2 + 1) * 512 + 64 * hm + d]) * (1.0f / 256.0f); }
    LAS int* thr = (LAS int*)(lds + EV_THR);
    LAS float* dtab = (LAS float*)(lds + EV_DTAB);
    dtab[tid] = rel_bias[t5_bucket(tid) * 16 + 8 + hm] * LOG2E;
    if (tid < 32) { tab[tid] = rel_bias[tid * 16 + 8 + hm] * LOG2E;
        int tv = tid; if (tid >= 16) { const int eb = (tid - 8) >> 1; tv = ((tid - 8) & 1) ? (int)(1.41421356f * (float)(1 << eb)) + 1 : (1 << eb); } thr[tid] = tv; }
    __syncthreads();
    {
        const int qid = tid & 255, half = tid >> 8;
        float v0 = -3e38f, v1 = -3e38f, v2 = -3e38f; int i0 = -1, i1 = -1, i2 = -1;
        if (own > 0) {
            float q[64]; const bf16* qp = Qh + ((size_t)own * 256 + qid) * 64;
#pragma unroll
            for (int c = 0; c < 8; ++c) { const u32x4 w = *(const u32x4*)(qp + c * 8);
                q[c * 8 + 0] = __uint_as_float(w.x << 16); q[c * 8 + 1] = __uint_as_float(w.x & 0xffff0000u); q[c * 8 + 2] = __uint_as_float(w.y << 16); q[c * 8 + 3] = __uint_as_float(w.y & 0xffff0000u);
                q[c * 8 + 4] = __uint_as_float(w.z << 16); q[c * 8 + 5] = __uint_as_float(w.z & 0xffff0000u); q[c * 8 + 6] = __uint_as_float(w.w << 16); q[c * 8 + 7] = __uint_as_float(w.w & 0xffff0000u); }
            for (int n = half; n < own; n += 2) { float g = 0.f; const LAS float* kmn = kmean + n * 64;
#pragma unroll
                for (int d = 0; d < 64; d += 4) { const f32x4 kv = *(const LAS f32x4*)(kmn + d); g += q[d] * kv[0] + q[d + 1] * kv[1] + q[d + 2] * kv[2] + q[d + 3] * kv[3]; }
                if (g > v0) { v2 = v1; i2 = i1; v1 = v0; i1 = i0; v0 = g; i0 = n; } else if (g > v1) { v2 = v1; i2 = i1; v1 = g; i1 = n; } else if (g > v2) { v2 = g; i2 = n; } }
        }
        LAS float* cv = (LAS float*)(lds + EV_KB); LAS int* ci = (LAS int*)(lds + EV_KB + 4096);
        if (half == 1) { cv[qid * 3] = v0; cv[qid * 3 + 1] = v1; cv[qid * 3 + 2] = v2; ci[qid * 3] = i0; ci[qid * 3 + 1] = i1; ci[qid * 3 + 2] = i2; }
        __syncthreads();
        if (half == 0) {
#pragma unroll
            for (int k = 0; k < 3; ++k) { const float g = cv[qid * 3 + k]; const int n = ci[qid * 3 + k];
                if (n >= 0) {
                    if (g > v0 || (g == v0 && n < i0)) { v2 = v1; i2 = i1; v1 = v0; i1 = i0; v0 = g; i0 = n; }
                    else if (g > v1 || (g == v1 && n < i1)) { v2 = v1; i2 = i1; v1 = g; i1 = n; }
                    else if (g > v2 || (g == v2 && n < i2)) { v2 = g; i2 = n; } } }
            unsigned mask = 0u;
            if (i0 >= 0) mask |= 1u << i0; if (i1 >= 0) mask |= 1u << i1; if (i2 >= 0) mask |= 1u << i2;
            selm[qid] = mask;
        }
    }
    __syncthreads();
    const unsigned msel = selm[32 * wid + l31];
    const int qw0 = own * 256 + 32 * wid, tq = qw0 + l31;
    s16x8 qf[4];
#pragma unroll
    for (int c = 0; c < 4; ++c) qf[c] = *(const s16x8*)(Qh + (size_t)tq * 64 + 16 * c + 8 * h);
    f32x16 o[2];
#pragma unroll
    for (int r = 0; r < 16; ++r) { o[0][r] = 0.f; o[1][r] = 0.f; }
    float m = -1e30f, l = 0.f;
    const int ntile = 4 * own + 4;
    Stage64 ra, rb; stage_load(ra, Kh, Vh, tid); stage_load(rb, Kh + 4096, Vh + 4096, tid);
    stage_write(ra, lds + EV_KB, lds + EV_VB, tid); stage_write(rb, lds + EV_KB + 9216, lds + EV_VB + 9216, tid);
    __syncthreads();
#define MOBA_TILE(T, SLOT) { const int t = (T); \
        const int n = t >> 2, key0 = 64 * t; const bool ownblk = (n == own); \
        const bool lane_sel = ((msel >> n) & 1u) != 0u; \
        const bool active = ownblk ? (key0 <= qw0 + 31) : (__any(lane_sel) != 0); \
        if (active) { \
            const lbyte* kb = lds + EV_KB + (SLOT) * 9216; const lbyte* vb = lds + EV_VB + (SLOT) * 9216; \
            f32x16 s[2]; s16x8 kf0[4], kf1[4], vf0[4], vf1[4]; \
            load_k<4>(kf0, kb, KP64, l31, h); load_k<4>(kf1, kb + 32 * KP64, KP64, l31, h); LDS_FENCE(); \
            qk2<4>(s[0], s[1], kf0, kf1, qf); \
            const int dmin = qw0 - (key0 + 63), dmax = qw0 + 31 - key0; \
            const int bmin = t5_bucket(dmin > 0 ? dmin : 0), bmax = t5_bucket(dmax); \
            if (!ownblk && bmax - bmin <= 1) {               \
                  \
                const float t0 = tab[bmin], t1 = tab[bmax]; const int th1 = thr[bmax]; \
                const float d1 = t1 - t0, tmax = fmaxf(t0, t1); \
                float mxr = s[0][0]; \
                _Pragma("unroll") for (int i = 0; i < 2; ++i) \
                    _Pragma("unroll") for (int r = 0; r < 16; ++r) mxr = fmaxf(mxr, s[i][r]); \
                mxr = pair_max(mxr); \
                const float cL = lane_sel ? 0.125f * LOG2E : 0.f, bL = lane_sel ? t0 : -INFINITY; \
                const float mx = lane_sel ? mxr * (0.125f * LOG2E) + tmax : -INFINITY; \
                  \
                const bool grow = mx > m + 8.0f; const float mn = grow ? mx : m, off = bL - mn; f32x2_t sum2 = {0.f, 0.f}; \
                if (__any(grow)) { const float alpha = __builtin_amdgcn_exp2f(m - mn); l *= alpha; o[0] = o[0] * alpha; o[1] = o[1] * alpha; } \
                m = mn; \
                if (bmax == bmin) { \
                    const f32x2_t c2 = {cL, cL}, o2 = {off, off}; \
                    _Pragma("unroll") for (int i = 0; i < 2; ++i) \
                        _Pragma("unroll") for (int r = 0; r < 16; r += 2) { f32x2_t v = {s[i][r], s[i][r + 1]}; v = v * c2 + o2; \
                            const float e0 = __builtin_amdgcn_exp2f(v.x), e1 = __builtin_amdgcn_exp2f(v.y); s[i][r] = e0; s[i][r + 1] = e1; sum2 += (f32x2_t){e0, e1}; } \
                } else {                                   \
                    const int x1 = tq - key0 - th1; const float offB = off + d1; \
                    _Pragma("unroll") for (int i = 0; i < 2; ++i) \
                        _Pragma("unroll") for (int r = 0; r < 16; r += 2) { const int kk = 32 * i + kkrow(r, h); \
                            const f32x2_t ob = {x1 >= kk ? offB : off, x1 >= kk + 1 ? offB : off}; f32x2_t v = {s[i][r], s[i][r + 1]}; v = v * (f32x2_t){cL, cL} + ob; \
                            const float e0 = __builtin_amdgcn_exp2f(v.x), e1 = __builtin_amdgcn_exp2f(v.y); s[i][r] = e0; s[i][r + 1] = e1; sum2 += (f32x2_t){e0, e1}; } \
                } \
                float sum = sum2.x + sum2.y; \
                sum = pair_sum(sum); l += sum; \
            } else {                                         \
                _Pragma("unroll") for (int i = 0; i < 2; ++i) { float bb[16]; \
                    _Pragma("unroll") for (int r = 0; r < 16; ++r) { const int dist = tq - (key0 + 32 * i + kkrow(r, h)); bb[r] = dtab[dist > 0 ? dist : 0]; } \
                    LDS_FENCE(); \
                    _Pragma("unroll") for (int r = 0; r < 16; ++r) { const int dist = tq - (key0 + 32 * i + kkrow(r, h)); \
                        const bool ok = ownblk ? (dist >= 0) : lane_sel; s[i][r] = ok ? s[i][r] * (0.125f * LOG2E) + bb[r] : -INFINITY; } } \
                softmax_upd<2, 2>(s, m, l, o); \
            } \
            load_v<2>(vf0, vb, KP64, l31, h); load_v<2>(vf1, vb + 64, KP64, l31, h); LDS_FENCE(); \
            s16x8 p0, p1; pack_p(s[0], p0, p1); pv1<2>(o, vf0, p0, p1); \
            pack_p(s[1], p0, p1); pv1<2>(o, vf1, p0, p1); \
        } }
#pragma unroll 1
    for (int st = 0; 2 * st < ntile; ++st) { const int cur2 = (st & 1) * 2, t0 = 2 * st; const bool more = t0 + 2 < ntile;
        if (more) { stage_load(ra, Kh + (size_t)(t0 + 2) * 4096, Vh + (size_t)(t0 + 2) * 4096, tid); stage_load(rb, Kh + (size_t)(t0 + 3) * 4096, Vh + (size_t)(t0 + 3) * 4096, tid); }
        MOBA_TILE(t0, cur2) MOBA_TILE(t0 + 1, cur2 + 1)
        if (more) { stage_write(ra, lds + EV_KB + (cur2 ^ 2) * 9216, lds + EV_VB + (cur2 ^ 2) * 9216, tid); stage_write(rb, lds + EV_KB + ((cur2 ^ 2) + 1) * 9216, lds + EV_VB + ((cur2 ^ 2) + 1) * 9216, tid); }
        __syncthreads(); }
#undef MOBA_TILE
    store_o<2>(o, 1.0f / l, AO + (rowbase + tq) * 1024 + ocol, h);
}

typedef short v4i16_t __attribute__((ext_vector_type(4)));
constexpr int MC_VPR = 144;
template <int DT> __device__ __forceinline__ void load_v_tr(s16x8* vf  , const lbyte* vrows, int lane) {
    const int hh = lane >> 5, blk = (lane >> 4) & 1, q = (lane & 15) >> 2, p = lane & 3;
    const lbyte* base = vrows + (8 * hh + q) * MC_VPR + (16 * blk + 4 * p) * 2;
#pragma unroll
    for (int dt = 0; dt < DT; ++dt)
#pragma unroll
        for (int ks = 0; ks < 2; ++ks) {
            const v4i16_t a = __builtin_amdgcn_ds_read_tr16_b64_v4i16((LAS v4i16_t*)(base + (16 * ks) * MC_VPR + 64 * dt));
            const v4i16_t c = __builtin_amdgcn_ds_read_tr16_b64_v4i16((LAS v4i16_t*)(base + (16 * ks + 4) * MC_VPR + 64 * dt));
            vf[dt * 2 + ks] = (s16x8){a[0], a[1], a[2], a[3], c[0], c[1], c[2], c[3]}; }
}
__device__ __forceinline__ void pack_p_nat(const f32x16& s, s16x8& p0, s16x8& p1) {
    unsigned a0 = pk2(s[0], s[1]), a1 = pk2(s[2], s[3]), b0 = pk2(s[4], s[5]), b1 = pk2(s[6], s[7]);
    unsigned c0 = pk2(s[8], s[9]), c1 = pk2(s[10], s[11]), d0 = pk2(s[12], s[13]), d1 = pk2(s[14], s[15]);
    { auto r = __builtin_amdgcn_permlane32_swap(a0, b0, false, false); a0 = r[0]; b0 = r[1]; }
    { auto r = __builtin_amdgcn_permlane32_swap(a1, b1, false, false); a1 = r[0]; b1 = r[1]; }
    { auto r = __builtin_amdgcn_permlane32_swap(c0, d0, false, false); c0 = r[0]; d0 = r[1]; }
    { auto r = __builtin_amdgcn_permlane32_swap(c1, d1, false, false); c1 = r[0]; d1 = r[1]; }
    p0 = __builtin_bit_cast(s16x8, (u32x4){a0, a1, b0, b1}); p1 = __builtin_bit_cast(s16x8, (u32x4){c0, c1, d0, d1});
}
constexpr int MC_Q = 0, MC_WB = 36864, MC_WBSZ = 9216, MC_KMEAN = MC_WB + 8 * MC_WBSZ, MC_LIST = MC_KMEAN + 8192, MC_CNT = MC_LIST + 16384, MC_DTAB = MC_CNT + 512, MC_NDT = 2900, MC_TAB = MC_DTAB + MC_NDT * 4, MC_END = MC_TAB + 256;
static_assert(MC_END <= LDS_RTAB + 12288 + 8192, "compact MoBA LDS below the pointer table");
constexpr int PART_PITCH = 144, PART_SLAB = 256 * 3 * PART_PITCH;
struct Sub32 { u32x4 k[4], v[4]; };
__device__ __forceinline__ void sub_load(Sub32& r, const bf16* kt, const bf16* vt, int lane) {
#pragma unroll
    for (int i = 0; i < 4; ++i) { r.k[i] = *(const u32x4*)(kt + (i * 64 + lane) * 8); r.v[i] = *(const u32x4*)(vt + (i * 64 + lane) * 8); }
}
__device__ __forceinline__ void sub_write(const Sub32& r, lbyte* kbuf, lbyte* vbuf, int lane) {
#pragma unroll
    for (int i = 0; i < 4; ++i) { const int ci = i * 64 + lane; *(LAS u32x4*)(kbuf + (ci >> 3) * KP64 + (ci & 7) * 16) = r.k[i]; *(LAS u32x4*)(vbuf + (ci >> 3) * MC_VPR + (ci & 7) * 16) = r.v[i]; }
}
template <bool CAUSAL> __device__ __forceinline__ void moba_span(lbyte* kbuf, lbyte* vbuf, const bf16* Kh, const bf16* Vh, int kpos0, int nsub, const s16x8* qf, int tq, bool valid, int qlo, int qhi,
                                          const LAS float* dtab, const LAS float* tab, const LAS int* thr, float& m, float& l, f32x16* o, int lane, int l31, int h) {
    Sub32 st; sub_load(st, Kh + (size_t)kpos0 * 64, Vh + (size_t)kpos0 * 64, lane);
#pragma unroll 1
    for (int su = 0; su < nsub; ++su) {
        const int key0 = kpos0 + 32 * su;
        sub_write(st, kbuf, vbuf, lane);
        if (su + 1 < nsub) sub_load(st, Kh + (size_t)(key0 + 32) * 64, Vh + (size_t)(key0 + 32) * 64, lane);
        s16x8 kf[4], vf[4]; f32x16 s[1];
        load_k<4>(kf, kbuf, KP64, l31, h); load_v_tr<2>(vf, vbuf, lane); LDS_FENCE();
        qk1<4>(s[0], kf, qf);
        const int dmin = qlo - (key0 + 31), dmax = qhi - key0;
        const int bmin = t5_bucket(dmin > 0 ? dmin : 0), bmax = t5_bucket(dmax > 0 ? dmax : 0);
        if (!CAUSAL && bmax - bmin <= 1) {
            const float t0 = tab[bmin], t1 = tab[bmax]; const int th1 = thr[bmax];
            float mxr = s[0][0];
#pragma unroll
            for (int r = 1; r < 16; ++r) mxr = fmaxf(mxr, s[0][r]);
            mxr = pair_max(mxr);
            const float cL = valid ? 0.125f * LOG2E : 0.f, bL = valid ? t0 : -INFINITY, mx = valid ? mxr * (0.125f * LOG2E) + fmaxf(t0, t1) : -INFINITY;
            const bool grow = mx > m + 8.0f; const float mn = grow ? mx : m, off = bL - mn, offB = off + (t1 - t0);
            if (__any(grow)) { const float alpha = __builtin_amdgcn_exp2f(m - mn); l *= alpha; o[0] = o[0] * alpha; o[1] = o[1] * alpha; }
            m = mn;
            const int x1 = (bmax > bmin) ? tq - key0 - th1 : -0x40000000; f32x2_t sum2 = {0.f, 0.f};
#pragma unroll
            for (int r = 0; r < 16; r += 2) { const int kk = kkrow(r, h);
                const f32x2_t ob = {x1 >= kk ? offB : off, x1 >= kk + 1 ? offB : off}; f32x2_t v = {s[0][r], s[0][r + 1]}; v = v * (f32x2_t){cL, cL} + ob;
                const float e0 = __builtin_amdgcn_exp2f(v.x), e1 = __builtin_amdgcn_exp2f(v.y); s[0][r] = e0; s[0][r + 1] = e1; sum2 += (f32x2_t){e0, e1}; }
            l += pair_sum(sum2.x + sum2.y);
        } else {
            float bb[16];
#pragma unroll
            for (int r = 0; r < 16; ++r) { int dist = tq - (key0 + kkrow(r, h)); dist = dist > 0 ? dist : 0; bb[r] = dtab[dist < MC_NDT - 1 ? dist : MC_NDT - 1]; }
            LDS_FENCE();
#pragma unroll
            for (int r = 0; r < 16; ++r) { const int dist = tq - (key0 + kkrow(r, h)); const bool ok = valid && (!CAUSAL || dist >= 0); s[0][r] = ok ? s[0][r] * (0.125f * LOG2E) + bb[r] : -INFINITY; }
            softmax_upd<1, 2>(s, m, l, o);
        }
        s16x8 p0, p1; pack_p_nat(s[0], p0, p1); pv1<2>(o, vf, p0, p1);
    }
}
__device__ __forceinline__ void part_store(unsigned char* pp, const f32x16* o, float m, float l, int h) {
#pragma unroll
    for (int dt = 0; dt < 2; ++dt)
#pragma unroll
        for (int g = 0; g < 4; ++g) { u32x2 w; w.x = pk2(o[dt][4 * g], o[dt][4 * g + 1]); w.y = pk2(o[dt][4 * g + 2], o[dt][4 * g + 3]); *(u32x2*)(pp + (32 * dt + 8 * g + 4 * h) * 2) = w; }
    if (h == 0) { *(float*)(pp + 128) = m; *(float*)(pp + 132) = l; }
}
__device__ __forceinline__ void moba_unit2(lbyte* lds, const bf16* QKV, bf16* AO, unsigned char* part, unsigned char* part3, const float* km2, const float* rel_bias, int b, int hm, int own) {
    const int tid = pg8::opaque_tid(), wid = __builtin_amdgcn_readfirstlane(tid >> 6), lane = tid & 63, l31 = lane & 31, h = lane >> 5;
    const int ocol = (8 + hm) * 64; const size_t rowbase = (size_t)b * SEQ, hbase = ((size_t)(b * 8 + hm) * SEQ) * 64;
    const bf16* Qh = QKV + 3 * EVSEG + hbase; const bf16* Kh = QKV + 4 * EVSEG + hbase; const bf16* Vh = QKV + 5 * EVSEG + hbase;
    LAS float* kmean = (LAS float*)(lds + MC_KMEAN); LAS unsigned short* list = (LAS unsigned short*)(lds + MC_LIST); LAS unsigned* cnt = (LAS unsigned*)(lds + MC_CNT);
    LAS unsigned* istart = cnt + 32; LAS unsigned* ctr = cnt + 72; LAS float* dtab = (LAS float*)(lds + MC_DTAB); LAS float* tab = (LAS float*)(lds + MC_TAB); LAS int* thr = (LAS int*)(lds + MC_TAB + 128);
    lbyte* kbuf = lds + MC_WB + wid * MC_WBSZ; lbyte* vbuf = kbuf + 32 * KP64;
    for (int i = tid; i < 256 * 8; i += NT) { const int row = i >> 3, ch = i & 7; *(LAS u32x4*)(lds + MC_Q + row * KP64 + ch * 16) = *(const u32x4*)(Qh + ((size_t)own * 256 + row) * 64 + ch * 8); }
    for (int idx = tid; idx < own * 64; idx += NT) { const int n = idx >> 6, d = idx & 63; const size_t blk = (size_t)b * 32 + n;
        kmean[idx] = (km2[(blk * 2 + 0) * 512 + 64 * hm + d] + km2[(blk * 2 + 1) * 512 + 64 * hm + d]) * (1.0f / 256.0f); }
    if (tid < 32) { tab[tid] = rel_bias[tid * 16 + 8 + hm] * LOG2E;
        int tv = tid; if (tid >= 16) { const int eb = (tid - 8) >> 1; tv = ((tid - 8) & 1) ? (int)(1.41421356f * (float)(1 << eb)) + 1 : (1 << eb); } thr[tid] = tv; }
    if (tid < 80) cnt[tid] = 0u;
    __syncthreads();
    for (int i = tid; i < MC_NDT; i += NT) dtab[i] = tab[t5_bucket(i)];
    {
        const int qid = tid & 255, half = tid >> 8;
        float v0 = -3e38f, v1 = -3e38f, v2 = -3e38f; int i0 = -1, i1 = -1, i2 = -1;
        if (own > 0) {
            float q[64]; const lbyte* qp = lds + MC_Q + qid * KP64;
#pragma unroll
            for (int c = 0; c < 8; ++c) { const u32x4 w = *(const LAS u32x4*)(qp + c * 16);
                q[c * 8 + 0] = __uint_as_float(w.x << 16); q[c * 8 + 1] = __uint_as_float(w.x & 0xffff0000u); q[c * 8 + 2] = __uint_as_float(w.y << 16); q[c * 8 + 3] = __uint_as_float(w.y & 0xffff0000u);
                q[c * 8 + 4] = __uint_as_float(w.z << 16); q[c * 8 + 5] = __uint_as_float(w.z & 0xffff0000u); q[c * 8 + 6] = __uint_as_float(w.w << 16); q[c * 8 + 7] = __uint_as_float(w.w & 0xffff0000u); }
            for (int n = half; n < own; n += 2) { float g = 0.f; const LAS float* kmn = kmean + n * 64;
#pragma unroll
                for (int d = 0; d < 64; d += 4) { const f32x4 kv = *(const LAS f32x4*)(kmn + d); g += q[d] * kv[0] + q[d + 1] * kv[1] + q[d + 2] * kv[2] + q[d + 3] * kv[3]; }
                if (g > v0) { v2 = v1; i2 = i1; v1 = v0; i1 = i0; v0 = g; i0 = n; } else if (g > v1) { v2 = v1; i2 = i1; v1 = g; i1 = n; } else if (g > v2) { v2 = g; i2 = n; } }
        }
        LAS float* cv = (LAS float*)(lds + MC_WB); LAS int* ci = (LAS int*)(lds + MC_WB + 4096);
        if (half == 1) { cv[qid * 3] = v0; cv[qid * 3 + 1] = v1; cv[qid * 3 + 2] = v2; ci[qid * 3] = i0; ci[qid * 3 + 1] = i1; ci[qid * 3 + 2] = i2; }
        __syncthreads();
        if (half == 0 && own > 0) {
#pragma unroll
            for (int k = 0; k < 3; ++k) { const float g = cv[qid * 3 + k]; const int n = ci[qid * 3 + k];
                if (n >= 0) {
                    if (g > v0 || (g == v0 && n < i0)) { v2 = v1; i2 = i1; v1 = v0; i1 = i0; v0 = g; i0 = n; }
                    else if (g > v1 || (g == v1 && n < i1)) { v2 = v1; i2 = i1; v1 = g; i1 = n; }
                    else if (g > v2 || (g == v2 && n < i2)) { v2 = g; i2 = n; } } }
            if (i0 >= 0) { const unsigned p = __hip_atomic_fetch_add(cnt + i0, 1u, __ATOMIC_RELAXED, __HIP_MEMORY_SCOPE_WORKGROUP); list[i0 * 256 + p] = (unsigned short)(qid | (0 << 8)); }
            if (i1 >= 0) { const unsigned p = __hip_atomic_fetch_add(cnt + i1, 1u, __ATOMIC_RELAXED, __HIP_MEMORY_SCOPE_WORKGROUP); list[i1 * 256 + p] = (unsigned short)(qid | (1 << 8)); }
            if (i2 >= 0) { const unsigned p = __hip_atomic_fetch_add(cnt + i2, 1u, __ATOMIC_RELAXED, __HIP_MEMORY_SCOPE_WORKGROUP); list[i2 * 256 + p] = (unsigned short)(qid | (2 << 8)); }
        }
    }
    __syncthreads();
    LAS unsigned char* itemn = (LAS unsigned char*)(lds + MC_KMEAN);
    if (tid == 0) { unsigned acc = 0u; for (int n = 0; n < own; ++n) { istart[n] = acc; const unsigned cn = (cnt[n] + 31u) >> 5; for (unsigned k = 0; k < cn; ++k) itemn[acc + k] = (unsigned char)n; acc += cn; } istart[own] = acc; }
    __syncthreads();
    const unsigned total = istart[own];
    {
        const int qid = 32 * wid + l31, tq = own * 256 + qid;
        s16x8 qf[4];
#pragma unroll
        for (int cc = 0; cc < 4; ++cc) qf[cc] = *(const LAS s16x8*)(lds + MC_Q + qid * KP64 + (16 * cc + 8 * h) * 2);
        f32x16 o[2];
#pragma unroll
        for (int r = 0; r < 16; ++r) { o[0][r] = 0.f; o[1][r] = 0.f; }
        float m = -1e30f, l = 0.f;
        moba_span<true>(kbuf, vbuf, Kh, Vh, 256 * own, wid + 1, qf, tq, true, own * 256 + 32 * wid, own * 256 + 32 * wid + 31, dtab, tab, thr, m, l, o, lane, l31, h);
        part_store(part3 + (size_t)qid * PART_PITCH, o, m, l, h);
    }
    for (;;) {
        unsigned it = 0u; if (lane == 0) it = __hip_atomic_fetch_add(ctr, 1u, __ATOMIC_RELAXED, __HIP_MEMORY_SCOPE_WORKGROUP);
        it = (unsigned)__builtin_amdgcn_readfirstlane((int)it);
        if (it >= total) break;
        const int n = __builtin_amdgcn_readfirstlane((int)itemn[it]);
        const int c = (int)(it - istart[n]), idx = 32 * c + l31; const bool valid = idx < (int)cnt[n];
        const unsigned ent = list[n * 256 + (valid ? idx : 32 * c)]; const int qid = ent & 255, slot = ent >> 8, tq = own * 256 + qid;
        s16x8 qf[4];
#pragma unroll
        for (int cc = 0; cc < 4; ++cc) qf[cc] = *(const LAS s16x8*)(lds + MC_Q + qid * KP64 + (16 * cc + 8 * h) * 2);
        f32x16 o[2];
#pragma unroll
        for (int r = 0; r < 16; ++r) { o[0][r] = 0.f; o[1][r] = 0.f; }
        float m = -1e30f, l = 0.f;
        moba_span<false>(kbuf, vbuf, Kh, Vh, 256 * n, 8, qf, tq, valid, own * 256, own * 256 + 255, dtab, tab, thr, m, l, o, lane, l31, h);
        if (valid) part_store(part + (size_t)(qid * 3 + slot) * PART_PITCH, o, m, l, h);
    }
    __syncthreads();
    {
        const int qid = 32 * wid + l31, tq = own * 256 + qid; const int nsel = own < 3 ? own : 3;
        float m = -1e30f, l = 0.f; f32x16 o[2];
#pragma unroll
        for (int r = 0; r < 16; ++r) { o[0][r] = 0.f; o[1][r] = 0.f; }
        for (int sl = -1; sl < nsel; ++sl) { const unsigned char* pp = sl < 0 ? part3 + (size_t)qid * PART_PITCH : part + (size_t)(qid * 3 + sl) * PART_PITCH;
            const float ms = *(const float*)(pp + 128), ls = *(const float*)(pp + 132);
            const float mn = fmaxf(m, ms), a = __builtin_amdgcn_exp2f(m - mn), bq = __builtin_amdgcn_exp2f(ms - mn);
            l = l * a + ls * bq; m = mn;
#pragma unroll
            for (int dt = 0; dt < 2; ++dt)
#pragma unroll
                for (int g = 0; g < 4; ++g) { const u32x2 w = *(const u32x2*)(pp + (32 * dt + 8 * g + 4 * h) * 2);
                    o[dt][4 * g] = o[dt][4 * g] * a + __uint_as_float(w.x << 16) * bq; o[dt][4 * g + 1] = o[dt][4 * g + 1] * a + __uint_as_float(w.x & 0xffff0000u) * bq;
                    o[dt][4 * g + 2] = o[dt][4 * g + 2] * a + __uint_as_float(w.y << 16) * bq; o[dt][4 * g + 3] = o[dt][4 * g + 3] * a + __uint_as_float(w.y & 0xffff0000u) * bq; } }
        store_o<2>(o, 1.0f / l, AO + (rowbase + tq) * 1024 + ocol, h);
    }
}

__device__ __forceinline__ void sb_unit(lbyte* lds, const bf16* QKV, bf16* AO, int b, int h8, int qblk) {
    const int tid = pg8::opaque_tid(), wid = __builtin_amdgcn_readfirstlane(tid >> 6), lane = tid & 63, l31 = lane & 31, h = lane >> 5;
    const int ocol = 64 * h8; const size_t rowbase = (size_t)b * SEQ, hbase = ((size_t)(b * 8 + h8) * SEQ) * 64;
    const bf16* Qh = QKV + 0 * EVSEG + hbase; const bf16* Kh = QKV + 1 * EVSEG + hbase; const bf16* Vh = QKV + 2 * EVSEG + hbase;
    LAS unsigned* flag = (LAS unsigned*)(lds + EV_FLAG);
    const int qw0 = qblk * 256 + 32 * wid, tq = qw0 + l31;
    s16x8 qf[4];
#pragma unroll
    for (int c = 0; c < 4; ++c) qf[c] = *(const s16x8*)(Qh + (size_t)tq * 64 + 16 * c + 8 * h);
    f32x16 o[2];
#pragma unroll
    for (int r = 0; r < 16; ++r) { o[0][r] = 0.f; o[1][r] = 0.f; }
    float C = 0.f; bool done = false;
    const int tlast = 4 * qblk + 3;
    Stage64 ra, rb; stage_load(ra, Kh + (size_t)tlast * 4096, Vh + (size_t)tlast * 4096, tid); stage_write(ra, lds + EV_KB, lds + EV_VB, tid);
    stage_load(ra, Kh + (size_t)(tlast - 1) * 4096, Vh + (size_t)(tlast - 1) * 4096, tid);
    __syncthreads();
    bool fin = false;
#define SB_STEP(IT, RCUR, RNXT) if (!fin) { const int it = (IT), t = tlast - it, cur = it & 1; \
        if (t >= 2) stage_load(RNXT, Kh + (size_t)(t - 2) * 4096, Vh + (size_t)(t - 2) * 4096, tid); \
        if (!done && 64 * t <= qw0 + 30) { \
            const lbyte* kb = lds + EV_KB + cur * 9216; const lbyte* vb = lds + EV_VB + cur * 9216; \
            s16x8 kfs[2][4], vfs[2][4]; f32x16 ss[2]; \
            load_k<4>(kfs[0], kb, KP64, l31, h); load_k<4>(kfs[1], kb + 32 * KP64, KP64, l31, h); load_v<2>(vfs[0], vb, KP64, l31, h); load_v<2>(vfs[1], vb + 64, KP64, l31, h); LDS_FENCE(); \
            qk2<4>(ss[0], ss[1], kfs[0], kfs[1], qf); \
            _Pragma("unroll") for (int sub = 1; sub >= 0; --sub) { \
                const int kmin = 64 * t + 32 * sub; \
                if (kmin <= qw0 + 30) { \
                    f32x16 s = ss[sub]; \
                    float ln[16]; \
                      \
                    _Pragma("unroll") for (int r = 0; r < 16; ++r) { const float z = s[r] * (0.125f * LOG2E); const bool valid = (kmin + kkrow(r, h)) < tq; \
                        const float e = __builtin_amdgcn_exp2f(-fabsf(z)); const float sp = fmaxf(z, 0.f) + __builtin_amdgcn_logf(1.0f + e); \
                        ln[r] = valid ? -sp : 0.f; s[r] = valid ? (z - sp) : -INFINITY; } \
                    float run = 0.f; \
                    _Pragma("unroll") for (int g = 3; g >= 0; --g) { const float G = (ln[4 * g] + ln[4 * g + 1]) + (ln[4 * g + 2] + ln[4 * g + 3]); const float P = pair_other(G, h); \
                        const float b3 = C + run + (h == 0 ? P : 0.f), b2 = b3 + ln[4 * g + 3], b1 = b2 + ln[4 * g + 2], b0 = b1 + ln[4 * g + 1]; \
                        s[4 * g + 3] = __builtin_amdgcn_exp2f(s[4 * g + 3] + b3); s[4 * g + 2] = __builtin_amdgcn_exp2f(s[4 * g + 2] + b2); s[4 * g + 1] = __builtin_amdgcn_exp2f(s[4 * g + 1] + b1); s[4 * g] = __builtin_amdgcn_exp2f(s[4 * g] + b0); \
                        run += G + P; } \
                    C += run; \
                    s16x8 p0, p1; pack_p(s, p0, p1); pv1<2>(o, vfs[sub], p0, p1); \
                } \
            } \
            done = __all(C < -127.0f) != 0;        \
        } \
        if (lane == 0) flag[cur * 8 + wid] = done ? 1u : 0u;        \
        if (t >= 1) stage_write(RCUR, lds + EV_KB + (cur ^ 1) * 9216, lds + EV_VB + (cur ^ 1) * 9216, tid); \
        __syncthreads(); \
        if (t == 0) fin = true; \
        else { bool alld = true; \
            _Pragma("unroll") for (int w = 0; w < 8; ++w) alld = alld && (flag[cur * 8 + w] != 0u); \
            if (alld) fin = true; } }
#pragma unroll 1
    for (int it2 = 0; !fin; it2 += 2) { SB_STEP(it2, ra, rb) SB_STEP(it2 + 1, rb, ra) }
#undef SB_STEP
    store_o<2>(o, 1.0f, AO + (rowbase + tq) * 1024 + ocol, h);
}

__device__ __forceinline__ void sb_unit2(lbyte* lds, const bf16* QKV, bf16* AO, int b, int h8, int qblk) {
    const int tid = pg8::opaque_tid(), wid = __builtin_amdgcn_readfirstlane(tid >> 6), lane = tid & 63, l31 = lane & 31, h = lane >> 5;
    const int ocol = 64 * h8; const size_t rowbase = (size_t)b * SEQ, hbase = ((size_t)(b * 8 + h8) * SEQ) * 64;
    const bf16* Qh = QKV + 0 * EVSEG + hbase; const bf16* Kh = QKV + 1 * EVSEG + hbase; const bf16* Vh = QKV + 2 * EVSEG + hbase;
    lbyte* kbuf = lds + MC_WB + wid * MC_WBSZ; lbyte* vbuf = kbuf + 32 * KP64;
    const int qw0 = qblk * 256 + 32 * wid, tq = qw0 + l31;
    s16x8 qf[4];
#pragma unroll
    for (int c = 0; c < 4; ++c) qf[c] = *(const s16x8*)(Qh + (size_t)tq * 64 + 16 * c + 8 * h);
    f32x16 o[2];
#pragma unroll
    for (int r = 0; r < 16; ++r) { o[0][r] = 0.f; o[1][r] = 0.f; }
    float C = 0.f;
    int su = qw0 >> 5;
    Sub32 st; sub_load(st, Kh + (size_t)su * 2048, Vh + (size_t)su * 2048, lane);
#pragma unroll 1
    for (; su >= 0; --su) {
        const int kmin = 32 * su;
        sub_write(st, kbuf, vbuf, lane);
        if (su > 0) sub_load(st, Kh + (size_t)(su - 1) * 2048, Vh + (size_t)(su - 1) * 2048, lane);
        s16x8 kf[4], vf[4]; f32x16 s;
        load_k<4>(kf, kbuf, KP64, l31, h); load_v_tr<2>(vf, vbuf, lane); LDS_FENCE();
        qk1<4>(s, kf, qf);
        float ln[16];
#pragma unroll
        for (int r = 0; r < 16; ++r) { const float z = s[r] * (0.125f * LOG2E); const bool valid = (kmin + kkrow(r, h)) < tq;
            const float e = __builtin_amdgcn_exp2f(-fabsf(z)); const float sp = fmaxf(z, 0.f) + __builtin_amdgcn_logf(1.0f + e);
            ln[r] = valid ? -sp : 0.f; s[r] = valid ? (z - sp) : -INFINITY; }
        float run = 0.f;
#pragma unroll
        for (int g = 3; g >= 0; --g) { const float G = (ln[4 * g] + ln[4 * g + 1]) + (ln[4 * g + 2] + ln[4 * g + 3]); const float P = pair_other(G, h);
            const float b3 = C + run + (h == 0 ? P : 0.f), b2 = b3 + ln[4 * g + 3], b1 = b2 + ln[4 * g + 2], b0 = b1 + ln[4 * g + 1];
            s[4 * g + 3] = __builtin_amdgcn_exp2f(s[4 * g + 3] + b3); s[4 * g + 2] = __builtin_amdgcn_exp2f(s[4 * g + 2] + b2); s[4 * g + 1] = __builtin_amdgcn_exp2f(s[4 * g + 1] + b1); s[4 * g] = __builtin_amdgcn_exp2f(s[4 * g] + b0);
            run += G + P; }
        C += run;
        s16x8 p0, p1; pack_p_nat(s, p0, p1); pv1<2>(o, vf, p0, p1);
        if (__all(C < -127.0f)) break;
    }
    store_o<2>(o, 1.0f, AO + (rowbase + tq) * 1024 + ocol, h);
}

constexpr int SW_K = 0, SW_V = 27648, SW_VP = 400  , SW_BT = SW_V + 64 * SW_VP, SW_END = SW_BT + 8 * 320 * 4;
__device__ __forceinline__ void swa_unit(lbyte* lds, const bf16* QKV, bf16* AO, const float* rel_bias, const float* sinks, int b, int hkv, int qb) {
    const int tid = pg8::opaque_tid(), wid = __builtin_amdgcn_readfirstlane(tid >> 6), lane = tid & 63, l31 = lane & 31, h = lane >> 5;
    constexpr int LD = 1280; const int hq = 8 * hkv + wid, qcol = 64 * hq, kcol = 1024 + 64 * hkv, vcol = 1152 + 64 * hkv;
    const size_t rowbase = (size_t)b * SEQ; const int q0 = 64 * qb, k0 = q0 - 128;
    LAS float* bt = (LAS float*)(lds + SW_BT);
#pragma unroll
    for (int i = tid; i < 192 * 8; i += NT) { const int row = i >> 3, ch = i & 7, key = k0 + row; u32x4 kv = (u32x4){0u, 0u, 0u, 0u}, vv = kv;
        if (key >= 0) { kv = *(const u32x4*)(QKV + (rowbase + key) * LD + kcol + ch * 8); vv = *(const u32x4*)(QKV + (rowbase + key) * LD + vcol + ch * 8); }
        *(LAS u32x4*)(lds + SW_K + row * KP64 + ch * 16) = kv;
        LAS unsigned short* vp = (LAS unsigned short*)(lds + SW_V + (ch * 8) * SW_VP + row * 2);
        vp[0 * (SW_VP / 2)] = (unsigned short)(vv.x & 0xffffu); vp[1 * (SW_VP / 2)] = (unsigned short)(vv.x >> 16); vp[2 * (SW_VP / 2)] = (unsigned short)(vv.y & 0xffffu); vp[3 * (SW_VP / 2)] = (unsigned short)(vv.y >> 16);
        vp[4 * (SW_VP / 2)] = (unsigned short)(vv.z & 0xffffu); vp[5 * (SW_VP / 2)] = (unsigned short)(vv.z >> 16); vp[6 * (SW_VP / 2)] = (unsigned short)(vv.w & 0xffffu); vp[7 * (SW_VP / 2)] = (unsigned short)(vv.w >> 16); }
#pragma unroll
    for (int i = tid; i < 8 * 320; i += NT) { const int w = i / 320, dist = i % 320 - 64; bt[i] = (dist >= 0 && dist < 128) ? rel_bias[t5_bucket(dist > 0 ? dist : 0) * 16 + 8 * hkv + w] * LOG2E : -INFINITY; }
    __syncthreads();
    const float sink = sinks[hq];
#pragma unroll 1
    for (int c = 0; c < 2; ++c) {
        const int qs = q0 + 32 * c, tq = qs + l31;
        s16x8 qf[4];
#pragma unroll
        for (int cc = 0; cc < 4; ++cc) qf[cc] = *(const s16x8*)(QKV + (rowbase + tq) * LD + qcol + 16 * cc + 8 * h);
        f32x16 o[2];
#pragma unroll
        for (int r = 0; r < 16; ++r) { o[0][r] = 0.f; o[1][r] = 0.f; }
        float m = -1e30f, l = 0.f;
#pragma unroll 1
        for (int j = 0; j < 6; ++j) { const int ks = k0 + 32 * j;
            if (ks > qs + 31 || ks + 31 < qs - 127 || ks + 31 < 0) continue;
            f32x16 s[1]; s16x8 kf[4], vf[4]; load_k<4>(kf, lds + SW_K + 32 * j * KP64, KP64, l31, h); load_v<2>(vf, lds + SW_V + 64 * j, SW_VP, l31, h); LDS_FENCE(); qk1<4>(s[0], kf, qf);
#pragma unroll
            for (int r = 0; r < 16; ++r) { const int key = ks + kkrow(r, h), dist = tq - key; const float bias = bt[wid * 320 + dist + 64]; s[0][r] = key >= 0 ? s[0][r] * (0.125f * LOG2E) + bias : -INFINITY; }
            softmax_upd<1, 2>(s, m, l, o);
            s16x8 p0, p1; pack_p(s[0], p0, p1); pv1<2>(o, vf, p0, p1);
        }
        store_o<2>(o, 1.0f / (l + __builtin_amdgcn_exp2f(sink * LOG2E - m)), AO + (rowbase + tq) * 1024 + qcol, h);
    }
}

constexpr int CX_KP = 272, CX_VP = 528, CX_K = 0, CX_V = 256 * CX_KP, CX_END = CX_V + 128 * CX_VP;
static_assert(CX_END <= LDS_BYTES && SW_END <= LDS_BYTES, "attention LDS");
__device__ __forceinline__ void cross_unit(lbyte* lds, bf16* CQ, const bf16* CKV, const float* gq, const float* gk, int layer, int b, int hc, int qblk0, int qstep, int nq) {
    const int tid = pg8::opaque_tid(), wid = __builtin_amdgcn_readfirstlane(tid >> 6), lane = tid & 63, l31 = lane & 31, h = lane >> 5;
    constexpr int LDK = 4096; const int kcol = layer * 1024 + hc * 128, vcol = kcol + 512;
#pragma unroll 4
    for (int i = tid; i < 256 * 16; i += NT) { const int row = i >> 4, ch = i & 15; const bf16* src = CKV + (size_t)(b * MEMLEN + row) * LDK;
        const u32x4 kv = *(const u32x4*)(src + kcol + ch * 8), vv = *(const u32x4*)(src + vcol + ch * 8);
        { float f[8]; f[0] = __uint_as_float(kv.x << 16); f[1] = __uint_as_float(kv.x & 0xffff0000u); f[2] = __uint_as_float(kv.y << 16); f[3] = __uint_as_float(kv.y & 0xffff0000u);
          f[4] = __uint_as_float(kv.z << 16); f[5] = __uint_as_float(kv.z & 0xffff0000u); f[6] = __uint_as_float(kv.w << 16); f[7] = __uint_as_float(kv.w & 0xffff0000u);
          float ss = (f[0] * f[0] + f[1] * f[1]) + (f[2] * f[2] + f[3] * f[3]) + (f[4] * f[4] + f[5] * f[5]) + (f[6] * f[6] + f[7] * f[7]);
          ss = pg8::row16_sum(ss); const float rn = __builtin_amdgcn_rsqf(ss * (1.0f / 128.0f) + 1e-6f);
          const f32x4 ga = *(const f32x4*)(gk + ch * 8), gb = *(const f32x4*)(gk + ch * 8 + 4);
          u32x4 kn; kn.x = pk2(f[0] * rn * ga[0], f[1] * rn * ga[1]); kn.y = pk2(f[2] * rn * ga[2], f[3] * rn * ga[3]); kn.z = pk2(f[4] * rn * gb[0], f[5] * rn * gb[1]); kn.w = pk2(f[6] * rn * gb[2], f[7] * rn * gb[3]);
          *(LAS u32x4*)(lds + CX_K + row * CX_KP + ch * 16) = kn; }
        LAS unsigned short* vp = (LAS unsigned short*)(lds + CX_V + (ch * 8) * CX_VP + row * 2);
        vp[0 * (CX_VP / 2)] = (unsigned short)(vv.x & 0xffffu); vp[1 * (CX_VP / 2)] = (unsigned short)(vv.x >> 16); vp[2 * (CX_VP / 2)] = (unsigned short)(vv.y & 0xffffu); vp[3 * (CX_VP / 2)] = (unsigned short)(vv.y >> 16);
        vp[4 * (CX_VP / 2)] = (unsigned short)(vv.z & 0xffffu); vp[5 * (CX_VP / 2)] = (unsigned short)(vv.z >> 16); vp[6 * (CX_VP / 2)] = (unsigned short)(vv.w & 0xffffu); vp[7 * (CX_VP / 2)] = (unsigned short)(vv.w >> 16); }
    __syncthreads();
#pragma unroll 1
    for (int qi = 0; qi < nq; ++qi) { const int qblk = qblk0 + qi * qstep;
    const size_t row = (size_t)b * SEQ + qblk * 256 + 32 * wid + l31;
    bf16* qrow = CQ + row * 512 + hc * 128;
    s16x8 qf[8];
#pragma unroll
    for (int c = 0; c < 8; ++c) qf[c] = *(const s16x8*)(qrow + 16 * c + 8 * h);
    { float ss = 0.f;
#pragma unroll
      for (int c = 0; c < 8; ++c)
#pragma unroll
          for (int e2 = 0; e2 < 8; ++e2) { const float f = bf2f((unsigned short)qf[c][e2]); ss += f * f; }
      ss = pair_sum(ss); const float rn = __builtin_amdgcn_rsqf(ss * (1.0f / 128.0f) + 1e-6f);
#pragma unroll
      for (int c = 0; c < 8; ++c) { const f32x4 ga = *(const f32x4*)(gq + 16 * c + 8 * h), gb = *(const f32x4*)(gq + 16 * c + 8 * h + 4); u32x4 w;
          w.x = pk2(bf2f((unsigned short)qf[c][0]) * rn * ga[0], bf2f((unsigned short)qf[c][1]) * rn * ga[1]); w.y = pk2(bf2f((unsigned short)qf[c][2]) * rn * ga[2], bf2f((unsigned short)qf[c][3]) * rn * ga[3]);
          w.z = pk2(bf2f((unsigned short)qf[c][4]) * rn * gb[0], bf2f((unsigned short)qf[c][5]) * rn * gb[1]); w.w = pk2(bf2f((unsigned short)qf[c][6]) * rn * gb[2], bf2f((unsigned short)qf[c][7]) * rn * gb[3]);
          qf[c] = __builtin_bit_cast(s16x8, w); } }
    f32x16 o[4];
#pragma unroll
    for (int r = 0; r < 16; ++r) { o[0][r] = 0.f; o[1][r] = 0.f; o[2][r] = 0.f; o[3][r] = 0.f; }
    float m = -1e30f, l = 0.f; const float scale = 0.08838834764831845f * LOG2E;
#pragma unroll 1
    for (int t = 0; t < 8; ++t) {
        f32x16 s[1]; s16x8 kf[8], vf[8];
        load_k<8>(kf, lds + CX_K + (32 * t) * CX_KP, CX_KP, l31, h); load_v<4>(vf, lds + CX_V + 64 * t, CX_VP, l31, h); LDS_FENCE();
        qk1<8>(s[0], kf, qf);
#pragma unroll
        for (int r = 0; r < 16; ++r) s[0][r] *= scale;
        softmax_upd<1, 4>(s, m, l, o);
        s16x8 p0, p1; pack_p(s[0], p0, p1); pv1<4>(o, vf, p0, p1);
    }
    store_o<4>(o, 1.0f / l, qrow, h);
    }
}

__device__ __forceinline__ void conv_item(const float* W, int K, int N, bf16* WT, const float* gain, int mapmode, bool f16, LAS float* scr, int item, int lane) {
    const int nblk = N / 32, kb = item / nblk, nb = item % nblk, k0 = 64 * kb, n0 = 32 * nb;
#pragma unroll 16
    for (int i = 0; i < 32; ++i) { const int kk = 2 * i + (lane >> 5); float v = __builtin_nontemporal_load(W + (size_t)(k0 + kk) * N + n0 + (lane & 31)); if (gain) v *= gain[k0 + kk]; scr[kk * 33 + (lane & 31)] = v; }
    asm volatile("s_waitcnt lgkmcnt(0)" ::: "memory");
    const int c = lane & 7;
#pragma unroll
    for (int j = 0; j < 4; ++j) { const int nl = (lane >> 3) + 8 * j; int n = n0 + nl;
        if (mapmode == 1) { n = n < DFF ? (n / 128) * 256 + (n % 128) : ((n - DFF) / 128) * 256 + 128 + ((n - DFF) % 128); }
        const LAS float* s = scr + (8 * c) * 33 + nl;
        u32x4 o; if (f16) { o.x = pg8::pk2h(s[0 * 33], s[1 * 33]); o.y = pg8::pk2h(s[2 * 33], s[3 * 33]); o.z = pg8::pk2h(s[4 * 33], s[5 * 33]); o.w = pg8::pk2h(s[6 * 33], s[7 * 33]); }
        else { o.x = pk2(s[0 * 33], s[1 * 33]); o.y = pk2(s[2 * 33], s[3 * 33]); o.z = pk2(s[4 * 33], s[5 * 33]); o.w = pk2(s[6 * 33], s[7 * 33]); }
        *(u32x4*)(WT + (size_t)n * K + k0 + 8 * c) = o; }
    asm volatile("s_waitcnt lgkmcnt(0)" ::: "memory");
}
__device__ __forceinline__ void conv_weight(const float* W, int K, int N, bf16* WT, const float* gain, int mapmode, bool f16, LAS float* scr, int gw, int ngw, int& off, int lane) {
    const int nitems = (K / 64) * (N / 32);
    int first = (gw - off) % ngw; if (first < 0) first += ngw;
    for (int it = first; it < nitems; it += ngw) conv_item(W, K, N, WT, gain, mapmode, f16, scr, it, lane);
    off = (off + nitems) % ngw;
}
__device__ __forceinline__ void row_prep(const float* xrow, float* xcopy, bf16* brow, float* ss, bool f16, int lane) {
    const f32x4* xr = (const f32x4*)xrow + lane; f32x4 v[4]; float s = 0.f;
#pragma unroll
    for (int j = 0; j < 4; ++j) { v[j] = __builtin_nontemporal_load(xr + 64 * j); s += (v[j][0] * v[j][0] + v[j][1] * v[j][1]) + (v[j][2] * v[j][2] + v[j][3] * v[j][3]); }
    s = wave_sum(s);
#pragma unroll
    for (int j = 0; j < 4; ++j) { if (xcopy) ((f32x4*)xcopy + lane)[64 * j] = v[j]; u32x2 w; if (f16) { w.x = pg8::pk2h(v[j][0], v[j][1]); w.y = pg8::pk2h(v[j][2], v[j][3]); } else { w.x = pk2(v[j][0], v[j][1]); w.y = pk2(v[j][2], v[j][3]); } ((u32x2*)brow + lane)[64 * j] = w; }
    if (lane < 16) ss[lane] = lane == 0 ? s : 0.f;
}
template <class Sched> __device__ __forceinline__ void fill_rtab(LAS float* rtab, const Sched& S, const float* ss) {
    pg8::Unit u; const int tix = pg8::opaque_tid();
#pragma unroll 4
    for (int i = 0; S.next(i, u) && i < 12; ++i) { if (tix < 256) { const f32x4* p = (const f32x4*)(ss + (size_t)(u.pm * 256 + tix) * 16);
            const f32x4 a = p[0], b = p[1], c = p[2], d = p[3]; const float t = ((a[0] + a[1]) + (a[2] + a[3])) + ((b[0] + b[1]) + (b[2] + b[3])) + ((c[0] + c[1]) + (c[2] + c[3])) + ((d[0] + d[1]) + (d[2] + d[3]));
            rtab[i * 256 + tix] = __builtin_amdgcn_rsqf(t * (1.0f / 1024.0f) + 1e-6f); } }
    __syncthreads();
}

#define XB_TMO      128
#define XB_XCNT(j)  (256  + 64 * (j))
#define XB_XSUB(j)  (1280 + 64 * (j))
#define XB_XGEN(j)  (2304 + 64 * (j))
#define XB_TOP      3328
#define XB_TOPGEN   3392
#define XCD_BAR_WORDS 3456
#define XB_SPIN_CAP (1u << 18)

__device__ __forceinline__ unsigned xb_ld(unsigned* p)              { return __hip_atomic_load(p, __ATOMIC_RELAXED, __HIP_MEMORY_SCOPE_AGENT); }
__device__ __forceinline__ unsigned xb_add(unsigned* p, unsigned v) { return __hip_atomic_fetch_add(p, v, __ATOMIC_RELAXED, __HIP_MEMORY_SCOPE_AGENT); }
__device__ __forceinline__ unsigned xb_xcc_id() { return (unsigned)__builtin_amdgcn_s_getreg((3 << 11) | 20) & 0xFu; }
#define XB_SPIN(cond, bar) do { unsigned _sp = 0; while (cond) { __builtin_amdgcn_s_sleep(1); \
    if ((++_sp & 255u) == 0u) { if (xb_ld(&(bar)[XB_TMO])) break; if (_sp > XB_SPIN_CAP) { atomicAdd(&(bar)[XB_TMO], 1u); break; } } } } while (0)

struct XcdBarrier {
    unsigned* bar; unsigned x;
    volatile LAS unsigned* st;
};

__device__ __forceinline__ XcdBarrier xcd_barrier_post(unsigned* bar, volatile LAS unsigned* st) {
    XcdBarrier b; b.bar = bar; b.x = xb_xcc_id(); b.st = st;
    if (threadIdx.x == 0) (void)xb_add(&bar[XB_XCNT(b.x)], 1u);
    return b;
}
__device__ __forceinline__ void xcd_barrier_complete(unsigned* bar, unsigned x, unsigned& nloc, unsigned& nx) {
    const unsigned G = gridDim.x * gridDim.y * gridDim.z;
    unsigned sum, cnt, mine, sp = 0u;
    for (;;) {
        sum = 0u; cnt = 0u; mine = 0u;
#pragma unroll
        for (unsigned j = 0; j < 16; ++j) { const unsigned c = xb_ld(&bar[XB_XCNT(j)]); sum += c; cnt += (c > 0u) ? 1u : 0u; mine = (j == x) ? c : mine; }
        if (sum == G) break;
        __builtin_amdgcn_s_sleep(1);
        if ((++sp & 255u) == 0u) { if (xb_ld(&bar[XB_TMO])) break; if (sp > XB_SPIN_CAP) { atomicAdd(&bar[XB_TMO], 1u); break; } }
    }
    nloc = mine > 0u ? mine : 1u; nx = cnt > 0u ? cnt : 1u;
}

__device__ __forceinline__ void xcd_barrier(const XcdBarrier& b) {
    asm volatile("s_waitcnt vmcnt(0)" ::: "memory");
    __syncthreads();
    if (threadIdx.x == 0) {
        unsigned* bar = b.bar;
        __builtin_amdgcn_s_waitcnt(0);
        unsigned nloc = b.st[0], nx = b.st[1];
        if (nloc == 0u) { xcd_barrier_complete(bar, b.x, nloc, nx); b.st[0] = nloc; b.st[1] = nx; }
        const unsigned old = xb_add(&bar[XB_XSUB(b.x)], 1u);
        const unsigned gen = old / nloc;
        if (old + 1u == (gen + 1u) * nloc) {
            __builtin_amdgcn_fence(__ATOMIC_RELEASE, "agent");
            asm volatile("s_waitcnt vmcnt(0)" ::: "memory");
            const unsigned og = xb_add(&bar[XB_TOP], 1u);
            const unsigned tg = og / nx;
            if (og + 1u == (tg + 1u) * nx) xb_add(&bar[XB_TOPGEN], 1u);
            else XB_SPIN(xb_ld(&bar[XB_TOPGEN]) == tg, bar);
            __builtin_amdgcn_fence(__ATOMIC_ACQUIRE, "agent");
            xb_add(&bar[XB_XGEN(b.x)], 1u);
            asm volatile("s_waitcnt vmcnt(0)" ::: "memory");
        } else {
            XB_SPIN(xb_ld(&bar[XB_XGEN(b.x)]) == gen, bar);
            __builtin_amdgcn_fence(__ATOMIC_ACQUIRE, "agent");
            asm volatile("s_waitcnt vmcnt(0)" ::: "memory");
        }
    }
    __syncthreads();
}


constexpr int NPHASE = 1 + 4 * 8;
constexpr int LDS_PT = LDS_EXCH + 8192;
__device__ __forceinline__ unsigned long long ldptr(const LAS unsigned long long* P, int k) {
    const unsigned long long v = P[k]; const unsigned lo = __builtin_amdgcn_readfirstlane((unsigned)v), hi = __builtin_amdgcn_readfirstlane((unsigned)(v >> 32));
    return ((unsigned long long)hi << 32) | lo;
}
#define GASP __attribute__((address_space(1)))
#define INP(k) ((const float*)(const GASP float*)ldptr(PT, (k)))
#define OUTP ((float*)(GASP float*)ldptr(PT, 25))
#define WSP(T, off) ((T*)(GASP T*)(ldptr(PT, 26) + (off)))
__global__ void __launch_bounds__(NT, 2) trunk_fwd(Args args) {
    extern __shared__ __attribute__((aligned(16))) unsigned char lds_raw[];
    lbyte* lds = (lbyte*)lds_raw;
    cg::grid_group grid = cg::this_grid();
    const int tid = threadIdx.x, wave = __builtin_amdgcn_readfirstlane(tid >> 6), G = gridDim.x, bx = blockIdx.x;
    LAS unsigned long long* PT = (LAS unsigned long long*)(lds + LDS_PT);
    if (tid == 0) {
#pragma unroll
        for (int i = 0; i < 25; ++i) PT[i] = (unsigned long long)args.in[i];
        PT[25] = (unsigned long long)args.out; PT[26] = (unsigned long long)args.ws;
        ((LAS unsigned*)(lds + LDS_PT + 256))[0] = 0u; ((LAS unsigned*)(lds + LDS_PT + 256))[1] = 0u;
        (void)xb_add((unsigned*)(args.ws + WS_CTL) + XB_XCNT(xb_xcc_id()), 1u);
    }
    __syncthreads();
    LAS float* rtab = (LAS float*)(lds + LDS_RTAB); LAS float* exch = (LAS float*)(lds + LDS_EXCH);
    const int lo = args.ph_lo, hi = args.ph_hi;
    if (lo > hi) grid.sync();
#define IN(k) (lo <= (k) && (k) < hi)
#define SEAM(k) do { if (IN(k) && IN((k) + 1)) { XcdBarrier xb_; xb_.bar = WSP(unsigned, WS_CTL); xb_.x = xb_xcc_id(); xb_.st = (volatile LAS unsigned*)(lds + LDS_PT + 256); xcd_barrier(xb_); } } while (0)

    if (IN(0)) {
        const int lane = pg8::opaque_tid() & 63;
        LAS float* scr = (LAS float*)(lds + wave * 8448);
        const int gw = bx * 8 + wave, ngw = G * 8; int off = 0;
        bf16* WB = WSP(bf16, WS_W);
        for (int i = 0; i < 2; ++i) {
            conv_weight(INP(4) + (size_t)i * 1024 * 3072, 1024, 3072, WB + W_EV_IN + (size_t)i * 3072 * 1024, INP(3) + (2 * i) * 1024, 0, RESID_F16 != 0, scr, gw, ngw, off, lane);
            conv_weight(INP(5) + (size_t)i * 1024 * 1024, 1024, 1024, WB + W_EV_OUT + (size_t)i * 1024 * 1024, nullptr, 0, false, scr, gw, ngw, off, lane);
            conv_weight(INP(8) + (size_t)i * 1024 * 1280, 1024, 1280, WB + W_OD_IN + (size_t)i * 1280 * 1024, INP(3) + (2 * i + 1) * 1024, 0, RESID_F16 != 0, scr, gw, ngw, off, lane);
            conv_weight(INP(9) + (size_t)i * 1024 * 1024, 1024, 1024, WB + W_OD_OUT + (size_t)i * 1024 * 1024, nullptr, 0, false, scr, gw, ngw, off, lane);
        }
        for (int l = 0; l < 4; ++l) {
            conv_weight(INP(15) + (size_t)l * 1024 * 512, 1024, 512, WB + W_CQ + (size_t)l * 512 * 1024, INP(13) + l * 1024, 0, RESID_F16 != 0, scr, gw, ngw, off, lane);
            conv_weight(INP(16) + (size_t)l * 1024 * 1024, 1024, 1024, WB + W_CKV + (size_t)l * 1024 * 1024, INP(14) + l * 1024, 0, false, scr, gw, ngw, off, lane);
            conv_weight(INP(17) + (size_t)l * 512 * 1024, 512, 1024, WB + W_CO + (size_t)l * 1024 * 512, nullptr, 0, false, scr, gw, ngw, off, lane);
            conv_weight(INP(21) + (size_t)l * 1024 * 5632, 1024, 5632, WB + W_UP + (size_t)l * 5632 * 1024, INP(20) + l * 1024, 1, RESID_F16 != 0, scr, gw, ngw, off, lane);
            conv_weight(INP(24) + (size_t)l * 2816 * 1024, 2816, 1024, WB + W_DN + (size_t)l * 1024 * 2816, nullptr, 0, false, scr, gw, ngw, off, lane);
        }
        { const float* xin = INP(0); bf16* XB = WSP(bf16, WS_XB); float* SS = WSP(float, WS_SS);
          for (int r = gw; r < M; r += ngw) row_prep(xin + (size_t)r * 1024, nullptr, XB + (size_t)r * 1024, SS + (size_t)r * 16, RESID_F16 != 0, lane); }
        { const float* min_ = INP(1); bf16* MEMB = WSP(bf16, WS_MEMB); float* SSM = WSP(float, WS_SSM);
          for (int r = gw; r < MROWS; r += ngw) row_prep(min_ + (size_t)r * 1024, nullptr, MEMB + (size_t)r * 1024, SSM + (size_t)r * 16, false, lane); }
        __syncthreads();
    }
    SEAM(0);

#pragma unroll 1
    for (int layer = 0; layer < 4; ++layer) {
        const int pb = 1 + 8 * layer, li = layer >> 1; const bool even = (layer & 1) == 0;
        if (IN(pb)) {
            if (layer == 0) {
                pg8::Gemm g{WSP(bf16, WS_MEMB), WSP(bf16, WS_W) + W_CKV, MROWS, 4096, 1024}; pg8::StaticOrder S; S.init(MROWS, 4096, G, bx);
                fill_rtab(rtab, S, WSP(float, WS_SSM));
                pg8::EpiProj<3> E{WSP(bf16, WS_CKV), 4096, rtab, exch, nullptr, INP(19), nullptr};
#ifndef SKIP_GEMM_EpiProj3
                pg8::gemm_phase<pg8::EpiProj<3>, pg8::StaticOrder, true, true>(lds + LDS_RING, g, S, E);
#endif
            }
            if (even) {
                pg8::Gemm g{WSP(bf16, WS_XB), WSP(bf16, WS_W) + W_EV_IN + (size_t)li * 3072 * 1024, M, 3072, 1024}; pg8::StaticOrder S; S.init(M, 3072, G, bx, WGM_IN);
                fill_rtab(rtab, S, WSP(float, WS_SS));
                pg8::EpiProj<0> E{WSP(bf16, WS_QKV), 3072, rtab, exch, INP(6) + li * 64, INP(7) + li * 64, WSP(float, WS_KM2)};
#ifndef SKIP_GEMM_EpiProj0
                pg8::gemm_phase<pg8::EpiProj<0>, pg8::StaticOrder, true, true>(lds + LDS_RING, g, S, E);
#endif
            } else {
                pg8::Gemm g{WSP(bf16, WS_XB), WSP(bf16, WS_W) + W_OD_IN + (size_t)li * 1280 * 1024, M, 1280, 1024}; pg8::StaticOrder S; S.init(M, 1280, G, bx);
                fill_rtab(rtab, S, WSP(float, WS_SS));
                pg8::EpiProj<1> E{WSP(bf16, WS_QKV), 1280, rtab, exch, INP(10) + li * 64, INP(11) + li * 64, nullptr};
#ifndef SKIP_GEMM_EpiProj1
                pg8::gemm_phase<pg8::EpiProj<1>, pg8::StaticOrder, true, true>(lds + LDS_RING, g, S, E);
#endif
            }
        }
        SEAM(pb);
#ifndef REP_ATTN
#define REP_ATTN 1
#endif
        if (IN(pb + 1)) for (int rep = 0; rep < (even ? REP_ATTN : 1); ++rep) {
            if (rep) grid.sync();
            if (even) {
                for (int u = bx; u < 2048; u += G) {
                    const int rnd = u / 256, w = u % 256, x = w % 8, j = w / 8, pr = 4 * x + (rnd & 3), b = pr / 8, hh = pr % 8;
                    if (rnd < 4) {
#ifndef SKIP_MOBA
#ifdef MOBA_DENSE
                        moba_unit(lds, WSP(bf16, WS_QKV), WSP(bf16, WS_AO), WSP(float, WS_KM2), INP(2), b, hh, (rnd & 1) ? j : 31 - j);
#else
                        moba_unit2(lds, WSP(bf16, WS_QKV), WSP(bf16, WS_AO), WSP(unsigned char, WS_CQ) + (size_t)bx * PART_SLAB, WSP(unsigned char, WS_HALO) + (size_t)bx * (256 * PART_PITCH), WSP(float, WS_KM2), INP(2), b, hh, (rnd & 1) ? j : 31 - j);
#endif
#endif
                    } else {
#ifndef SKIP_SB
#ifdef SB_SHARED
                        sb_unit(lds, WSP(bf16, WS_QKV), WSP(bf16, WS_AO), b, hh, j);
#else
                        sb_unit2(lds, WSP(bf16, WS_QKV), WSP(bf16, WS_AO), b, hh, j);
#endif
#endif
                    }
                    __syncthreads();
                }
            } else {
                for (int u = bx; u < 1024; u += G) { const int rem = u % 8, b = rem / 2, hkv = rem % 2, qb = u / 8;
#ifndef SKIP_SWA
                    swa_unit(lds, WSP(bf16, WS_QKV), WSP(bf16, WS_AO), INP(2), INP(12) + li * 16, b, hkv, qb);
#endif
                    __syncthreads(); }
            }
        }
        SEAM(pb + 1);
        if (IN(pb + 2)) {
            pg8::Gemm g{WSP(bf16, WS_AO), WSP(bf16, WS_W) + (even ? W_EV_OUT : W_OD_OUT) + (size_t)li * 1024 * 1024, M, 1024, 1024}; pg8::StaticOrder S; S.init(M, 1024, G, bx);
            pg8::EpiRes<false, false> E{nullptr, nullptr, WSP(bf16, WS_XB), WSP(float, WS_SS)};
#ifndef SKIP_GEMM_EpiRes
            pg8::gemm_phase<pg8::EpiRes<false, false>, pg8::StaticOrder, true, true>(lds + LDS_RING, g, S, E);
#endif
        }
        SEAM(pb + 2);
        if (IN(pb + 3)) {
            pg8::Gemm g{WSP(bf16, WS_XB), WSP(bf16, WS_W) + W_CQ + (size_t)layer * 512 * 1024, M, 512, 1024}; pg8::StaticOrder S; S.init(M, 512, G, bx);
            fill_rtab(rtab, S, WSP(float, WS_SS));
            pg8::EpiProj<2> E{WSP(bf16, WS_CQ), 512, rtab, exch, INP(18) + layer * 128, nullptr, nullptr};
#ifndef SKIP_GEMM_EpiProj2
            pg8::gemm_phase<pg8::EpiProj<2>, pg8::StaticOrder, true, true>(lds + LDS_RING, g, S, E);
#endif
        }
        SEAM(pb + 3);
        if (IN(pb + 4)) {
            if (G % 16 == 0) {
                const int rem = bx % 16, nq = (32 - bx / 16 + G / 16 - 1) / (G / 16);
#ifndef SKIP_CROSS
                if (bx / 16 < 32) cross_unit(lds, WSP(bf16, WS_CQ), WSP(bf16, WS_CKV), INP(18) + layer * 128, INP(19) + layer * 128, layer, rem / 4, rem % 4, bx / 16, G / 16, nq);
#endif
                __syncthreads();
            } else {
                for (int u = bx; u < 512; u += G) { const int rem = u % 16;
#ifndef SKIP_CROSS
                    cross_unit(lds, WSP(bf16, WS_CQ), WSP(bf16, WS_CKV), INP(18) + layer * 128, INP(19) + layer * 128, layer, rem / 4, rem % 4, u / 16, 0, 1);
#endif
                    __syncthreads(); }
            }
        }
        SEAM(pb + 4);
        if (IN(pb + 5)) {
            pg8::Gemm g{WSP(bf16, WS_CQ), WSP(bf16, WS_W) + W_CO + (size_t)layer * 1024 * 512, M, 1024, 512}; pg8::StaticOrder S; S.init(M, 1024, G, bx);
            pg8::EpiRes<false, false> E{nullptr, nullptr, WSP(bf16, WS_XB), WSP(float, WS_SS)};
#ifndef SKIP_GEMM_EpiRes
            pg8::gemm_phase<pg8::EpiRes<false, false>, pg8::StaticOrder, true, true>(lds + LDS_RING, g, S, E);
#endif
        }
        SEAM(pb + 5);
#ifndef REP_UP
#define REP_UP 1
#endif
        if (IN(pb + 6)) for (int rep = 0; rep < REP_UP; ++rep) {
            if (rep) grid.sync();
            pg8::Gemm g{WSP(bf16, WS_XB), WSP(bf16, WS_W) + W_UP + (size_t)layer * 5632 * 1024, M, 5632, 1024}; pg8::StaticOrder S; S.init(M, 5632, G, bx, WGM_UP);
            fill_rtab(rtab, S, WSP(float, WS_SS));
            pg8::EpiFfnUp E{WSP(bf16, WS_G), rtab, exch, INP(22) + (size_t)layer * 3 * 5632, INP(23) + (size_t)layer * 5632, WSP(float, WS_HALO)};
#ifndef SKIP_GEMM_EpiFfnUp
            pg8::gemm_phase<pg8::EpiFfnUp, pg8::StaticOrder, true, true>(lds + LDS_RING, g, S, E);
#endif
        }
        SEAM(pb + 6);
        if (IN(pb + 7)) {
            pg8::StaticOrder S; S.init(M, 1024, G, bx);
            { const float* cw = INP(22) + (size_t)layer * 3 * 5632; const float* cb = INP(23) + (size_t)layer * 5632; const float* HALO = WSP(float, WS_HALO); bf16* GB = WSP(bf16, WS_G);
            pg8::Unit u;
            for (int i = 0; S.next(i, u); ++i) {
                const bool first = (u.pm % 32) == 0;
                for (int f = pg8::opaque_tid(); f < DFF; f += NT) { float cg0[2], cg1[2];
#pragma unroll
                    for (int part = 0; part < 2; ++part) { const int ch = part * DFF + f;
                        const float um2 = first ? 0.f : HALO[(size_t)((u.pm - 1) * 4 + 2) * 5632 + ch], um1 = first ? 0.f : HALO[(size_t)((u.pm - 1) * 4 + 3) * 5632 + ch];
                        const float u0 = HALO[(size_t)(u.pm * 4 + 0) * 5632 + ch], u1 = HALO[(size_t)(u.pm * 4 + 1) * 5632 + ch];
                        const float w0 = cw[ch], w1 = cw[5632 + ch], w2 = cw[2 * 5632 + ch], bb = cb[ch];
                        cg0[part] = bb + w0 * um2 + w1 * um1 + w2 * u0; cg1[part] = bb + w0 * um1 + w1 * u0 + w2 * u1; }
                    const float g0 = cg0[0] / (1.0f + __expf(-cg0[0])) * cg0[1], g1 = cg1[0] / (1.0f + __expf(-cg1[0])) * cg1[1];
                    GB[(size_t)(u.pm * 256) * DFF + f] = (bf16)(pk2(g0, 0.f) & 0xffffu); GB[(size_t)(u.pm * 256 + 1) * DFF + f] = (bf16)(pk2(g1, 0.f) & 0xffffu); }
            } }
            __syncthreads();
            pg8::Gemm g{WSP(bf16, WS_G), WSP(bf16, WS_W) + W_DN + (size_t)layer * 1024 * 2816, M, 1024, 2816};
            if (layer == 3) { pg8::EpiRes<false, true> E{nullptr, OUTP, WSP(bf16, WS_XB), WSP(float, WS_SS)};
#ifndef SKIP_GEMM_EpiRes
                pg8::gemm_phase<pg8::EpiRes<false, true>, pg8::StaticOrder, true, true>(lds + LDS_RING, g, S, E);
#endif
            } else { pg8::EpiRes<false, false> E{nullptr, nullptr, WSP(bf16, WS_XB), WSP(float, WS_SS)};
#ifndef SKIP_GEMM_EpiRes
                pg8::gemm_phase<pg8::EpiRes<false, false>, pg8::StaticOrder, true, true>(lds + LDS_RING, g, S, E);
#endif
            }
        }
        SEAM(pb + 7);
    }
#undef IN
#undef SEAM
}

#ifndef MK_SPLIT
#define MK_SPLIT 0
#endif
extern "C" void kernel_launch(void* const* d_in, const int* in_sizes, int n_in, void* d_out, int out_size, void* d_ws, size_t ws_size, hipStream_t stream) {
    static int grid = 0;
    if (grid == 0) {
        if (n_in != 25 || out_size != M * D || ws_size < WS_END) { fprintf(stderr, "kernel_launch: unexpected shapes (n_in %d out %d ws %zu)\n", n_in, out_size, ws_size); grid = -1; return; }
        int dev = 0, cus = 0, per_cu = 0;
        hipGetDevice(&dev); hipDeviceGetAttribute(&cus, hipDeviceAttributeMultiprocessorCount, dev);
        if (hipFuncSetAttribute((const void*)trunk_fwd, hipFuncAttributeMaxDynamicSharedMemorySize, LDS_BYTES) != hipSuccess) { fprintf(stderr, "kernel_launch: hipFuncSetAttribute failed\n"); }
        if (hipOccupancyMaxActiveBlocksPerMultiprocessor(&per_cu, (const void*)trunk_fwd, NT, LDS_BYTES) != hipSuccess || per_cu < 1) { fprintf(stderr, "kernel_launch: occupancy query says %d\n", per_cu); per_cu = 1; }
        (void)hipGetLastError();
        grid = cus * (per_cu > 1 ? 1 : per_cu);
    }
    if (grid < 0) return;
    if (hipMemsetAsync((char*)d_ws + WS_CTL, 0, CTL_BYTES, stream) != hipSuccess) { fprintf(stderr, "kernel_launch: memset failed\n"); return; }
    Args a{};
    for (int i = 0; i < 25; ++i) a.in[i] = (const float*)d_in[i];
    a.out = (float*)d_out; a.ws = (unsigned char*)d_ws;
#if MK_SPLIT
    for (int p = 0; p < NPHASE; ++p) { a.ph_lo = p; a.ph_hi = p + 1; void* kargs[] = {&a};
        hipError_t e = hipLaunchCooperativeKernel((const void*)trunk_fwd, dim3(grid), dim3(NT), kargs, LDS_BYTES, stream);
        if (e != hipSuccess) { fprintf(stderr, "launch %d failed: %s\n", p, hipGetErrorString(e)); break; } }
#else
    a.ph_lo = 0; a.ph_hi = NPHASE; void* kargs[] = {&a};
    hipError_t e = hipLaunchCooperativeKernel((const void*)trunk_fwd, dim3(grid), dim3(NT), kargs, LDS_BYTES, stream);
    if (e != hipSuccess) fprintf(stderr, "cooperative launch failed: %s (grid %d)\n", hipGetErrorString(e), grid);
#endif
}
```
